# Optimizing an MI355X kernel written in HIP

```python
import math
import jax, jax.numpy as jnp
from jax import lax
import numpy as np

D_MODEL = 2048
BATCH = 1
SEQ = 16384
DEPTH = 4

N_MIXERS = 2
N_ATTN_LAYERS = (DEPTH + 1) // 2
N_POOL_LAYERS = DEPTH // 2

N_HEADS = 8
HEAD_DIM = D_MODEL // (2 * N_HEADS)
V_HEAD_DIM = 2 * HEAD_DIM
ROT_DIM = HEAD_DIM // 4
ROPE_THETA = 500000.0
Q_BLOCK = 128
LAMBDA_STD = 0.1

POOL_WINDOWS = (2, 4, 8, 16)
N_POOL_GROUPS = len(POOL_WINDOWS)
POOL_GROUP_DIM = D_MODEL // N_POOL_GROUPS

N_EXPERTS = 64
N_EXPERT_GROUPS = 8
EXPERTS_PER_GROUP = N_EXPERTS // N_EXPERT_GROUPS
TOP_K = 2
D_FF_EXPERT = D_MODEL // 4

DEEPNORM_ALPHA = (2.0 * DEPTH) ** 0.25
DEEPNORM_BETA = (8.0 * DEPTH) ** -0.25
LN_EPS = 1e-5
RMS_EPS = 1e-5

kernel_name = 'hybrid_diffattn_pool_grouped_moe_deepnorm'


def layer_norm(x, g, b):
    xf = x.astype(jnp.float32)
    mu = jnp.mean(xf, axis=-1, keepdims=True)
    var = jnp.mean(jnp.square(xf - mu), axis=-1, keepdims=True)
    y = (xf - mu) * lax.rsqrt(var + LN_EPS) * g.astype(jnp.float32) + b.astype(jnp.float32)
    return y.astype(x.dtype)


def lambda_init_fn(layer):
    return 0.8 - 0.6 * math.exp(-0.3 * layer)


def partial_rotary(t, cos, sin):
    half = ROT_DIM // 2
    tf = t.astype(jnp.float32)
    c = cos[None, :, None, None, :]
    s = sin[None, :, None, None, :]
    t1 = tf[..., :half]
    t2 = tf[..., half:ROT_DIM]
    out = jnp.concatenate([t1 * c - t2 * s, t2 * c + t1 * s, tf[..., ROT_DIM:]], axis=-1)
    return out.astype(t.dtype)


def diff_attention(x, w_qkv, lam_qk, subln_g, w_o, layer):
    B, S, D = x.shape
    qkv = x @ w_qkv
    q, k, v = jnp.split(qkv, 3, axis=-1)
    q = q.reshape(B, S, N_HEADS, 2, HEAD_DIM)
    k = k.reshape(B, S, N_HEADS, 2, HEAD_DIM)
    v = v.reshape(B, S, N_HEADS, V_HEAD_DIM)
    pos = jnp.arange(S, dtype=jnp.float32)
    inv_freq = ROPE_THETA ** (-jnp.arange(0, ROT_DIM, 2, dtype=jnp.float32) / ROT_DIM)
    ang = pos[:, None] * inv_freq[None, :]
    cos, sin = jnp.cos(ang), jnp.sin(ang)
    q = partial_rotary(q, cos, sin) * (HEAD_DIM ** -0.5)
    k = partial_rotary(k, cos, sin)
    lf = lam_qk.astype(jnp.float32)
    lam_init = lambda_init_fn(layer)
    lam = jnp.exp(jnp.sum(lf[0] * lf[1])) - jnp.exp(jnp.sum(lf[2] * lf[3])) + lam_init
    n_blocks = S // Q_BLOCK
    q_blocks = q.reshape(B, n_blocks, Q_BLOCK, N_HEADS, 2, HEAD_DIM).transpose(1, 0, 2, 3, 4, 5)

    def attend(qb):
        s = jnp.einsum('bqhcd,bkhcd->bhcqk', qb, k, preferred_element_type=jnp.float32)
        p = jax.nn.softmax(s, axis=-1)
        a = p[:, :, 0] - lam * p[:, :, 1]
        return jnp.einsum('bhqk,bkhe->bqhe', a.astype(v.dtype), v)

    o = lax.map(attend, q_blocks)
    o = o.transpose(1, 0, 2, 3, 4).reshape(B, S, N_HEADS, V_HEAD_DIM)
    of = o.astype(jnp.float32)
    of = of * lax.rsqrt(jnp.mean(jnp.square(of), axis=-1, keepdims=True) + RMS_EPS)
    of = of * subln_g.astype(jnp.float32) * (1.0 - lam_init)
    return of.astype(x.dtype).reshape(B, S, D) @ w_o


def multiscale_pool(x, w_pool, scale):
    B, S, D = x.shape
    xg = x.astype(jnp.float32).reshape(B, S, N_POOL_GROUPS, POOL_GROUP_DIM)
    csum = jnp.concatenate([jnp.zeros_like(xg[:, :1]), jnp.cumsum(xg, axis=1)], axis=1)
    t = jnp.arange(S)
    diffs = []
    for g, w in enumerate(POOL_WINDOWS):
        half = w // 2
        lo = jnp.clip(t - half, 0, S)
        hi = jnp.clip(t + half, 0, S)
        win_sum = csum[:, hi, g] - csum[:, lo, g]
        cnt = (hi - lo).astype(jnp.float32)[None, :, None]
        diffs.append(win_sum / cnt - xg[:, :, g])
    d = jnp.stack(diffs, axis=2).astype(x.dtype)
    y = jnp.einsum('bsgc,gce->bsge', d, w_pool).reshape(B, S, D)
    return y * scale


def grouped_moe(x, router_w, router_b, w_in, w_out):
    B, S, D = x.shape
    T = B * S
    xt = x.reshape(T, D)
    logits = jnp.dot(xt, router_w, preferred_element_type=jnp.float32)
    scores = jax.nn.sigmoid(logits)
    biased = scores + router_b.astype(jnp.float32)
    grp = biased.reshape(T, N_EXPERT_GROUPS, EXPERTS_PER_GROUP)
    grp_score = jnp.sum(lax.top_k(grp, TOP_K)[0], axis=-1)
    best = jnp.argmax(grp_score, axis=-1)
    in_grp = jnp.arange(N_EXPERT_GROUPS)[None, :] == best[:, None]
    masked = jnp.where(in_grp[:, :, None], grp, -jnp.inf).reshape(T, N_EXPERTS)
    _, idx = lax.top_k(masked, TOP_K)
    gate = jnp.take_along_axis(scores, idx, axis=-1)
    gate = gate / jnp.sum(gate, axis=-1, keepdims=True)
    flat_e = idx.reshape(-1)
    flat_tok = jnp.repeat(jnp.arange(T), TOP_K)
    order = jnp.argsort(flat_e)
    tok_sorted = flat_tok[order]
    gate_sorted = gate.reshape(-1)[order]
    sizes = jnp.bincount(flat_e, length=N_EXPERTS).astype(jnp.int32)
    xs = xt[tok_sorted]
    h = lax.ragged_dot(xs, w_in, sizes)
    hg, hu = jnp.split(h, 2, axis=-1)
    h = jax.nn.silu(hg) * hu
    y = lax.ragged_dot(h, w_out, sizes) * gate_sorted[:, None].astype(x.dtype)
    return jax.ops.segment_sum(y, tok_sorted, num_segments=T).reshape(B, S, D)


def setup_inputs(seed: int = 0) -> dict:
    key = jax.random.key(seed)
    ks = jax.random.split(key, 14)
    f32 = jnp.float32
    D = D_MODEL
    F = D_FF_EXPERT
    C = POOL_GROUP_DIM

    def nrm(k, shape, std):
        return jax.random.normal(k, shape, f32) * std

    x = nrm(ks[0], (BATCH, SEQ, D), 1.0)
    w_qk = nrm(ks[1], (N_ATTN_LAYERS, D, 2 * D), D ** -0.5)
    w_v = nrm(ks[2], (N_ATTN_LAYERS, D, D), DEEPNORM_BETA * D ** -0.5)
    w_qkv = jnp.concatenate([w_qk, w_v], axis=-1)
    lambda_qk = nrm(ks[3], (N_ATTN_LAYERS, 4, HEAD_DIM), LAMBDA_STD)
    subln_g = 1.0 + nrm(ks[4], (N_ATTN_LAYERS, V_HEAD_DIM), 0.02)
    w_o = nrm(ks[5], (N_ATTN_LAYERS, D, D), DEEPNORM_BETA * D ** -0.5)
    pool_w = nrm(ks[6], (N_POOL_LAYERS, N_POOL_GROUPS, C, C), DEEPNORM_BETA * C ** -0.5)
    pool_scale = 1.0 + nrm(ks[7], (N_POOL_LAYERS, D), 0.02)
    router_w = nrm(ks[8], (D, N_EXPERTS), D ** -0.5)
    router_b = nrm(ks[9], (N_EXPERTS,), 0.01)
    moe_w_in = nrm(ks[10], (DEPTH, N_EXPERTS, D, 2 * F), DEEPNORM_BETA * D ** -0.5)
    moe_w_out = nrm(ks[11], (DEPTH, N_EXPERTS, F, D), DEEPNORM_BETA * F ** -0.5)
    ln_g = 1.0 + nrm(ks[12], (DEPTH, 2, D), 0.02)
    ln_b = nrm(ks[13], (DEPTH, 2, D), 0.02)
    return {'x': x, 'w_qkv': w_qkv, 'lambda_qk': lambda_qk, 'subln_g': subln_g, 'w_o': w_o,
            'pool_w': pool_w, 'pool_scale': pool_scale, 'router_w': router_w, 'router_b': router_b,
            'moe_w_in': moe_w_in, 'moe_w_out': moe_w_out, 'ln_g': ln_g, 'ln_b': ln_b}


def reference(x, w_qkv, lambda_qk, subln_g, w_o, pool_w, pool_scale, router_w, router_b,
              moe_w_in, moe_w_out, ln_g, ln_b):
    h = x
    for i in range(DEPTH):
        j = i // N_MIXERS
        if i % N_MIXERS == 0:
            mix = diff_attention(h, w_qkv[j], lambda_qk[j], subln_g[j], w_o[j], i)
        else:
            mix = multiscale_pool(h, pool_w[j], pool_scale[j])
        h = layer_norm(DEEPNORM_ALPHA * h + mix, ln_g[i, 0], ln_b[i, 0])
        ffn = grouped_moe(h, router_w, router_b, moe_w_in[i], moe_w_out[i])
        h = layer_norm(DEEPNORM_ALPHA * h + ffn, ln_g[i, 1], ln_b[i, 1])
    return h
```

```cpp
#include <hip/hip_runtime.h>
#include <stdint.h>
#include <stdio.h>

#ifndef PHMASK
#define PHMASK 0xFFFF
#endif
#ifndef PROBE_BAR
#define PROBE_BAR 0
#endif
#ifndef REP_ROUTE
#define REP_ROUTE 1
#endif
#ifndef PROBE_RMODE
#define PROBE_RMODE 0
#endif
#ifndef PROBE_GMFMA
#define PROBE_GMFMA 0
#endif
#ifndef REP_ATT
#define REP_ATT 1
#endif
#ifndef REP_GEMM
#define REP_GEMM 1
#endif
#ifndef REP_MOE
#define REP_MOE 1
#endif
#ifndef REP_PRO
#define REP_PRO 1
#endif
#ifndef REP_TOK
#define REP_TOK 1
#endif
#define REPEAT(n) _Pragma("unroll 1") for (int rep_ = 0; rep_ < (n); ++rep_)
#ifndef ONE_LAUNCH
#define ONE_LAUNCH 1
#endif

#define LAS __attribute__((address_space(3)))
typedef unsigned short bf16_t;
typedef short bf16x8 __attribute__((ext_vector_type(8)));
typedef short s16x4 __attribute__((ext_vector_type(4)));
typedef float f32x2 __attribute__((ext_vector_type(2)));
typedef float f32x4 __attribute__((ext_vector_type(4)));
typedef float f32x16 __attribute__((ext_vector_type(16)));
typedef unsigned u32x2 __attribute__((ext_vector_type(2)));
typedef unsigned u32x4 __attribute__((ext_vector_type(4)));

constexpr int S = 16384, D = 2048, DEPTH = 4, NE = 64, DFF = 512, NH = 8, HD = 128, VD = 256;
constexpr float ALPHA = 1.6817928305074292f;
constexpr float LN_EPS = 1e-5f, RMS_EPS = 1e-5f;
constexpr int NTHREADS = 512;
constexpr int SEGCAP = S;

constexpr size_t AL(size_t x) { return (x + 255) / 256 * 256; }
constexpr size_t WS_CTL   = 0;
constexpr size_t CTL_BAR_WORDS = 3456;
constexpr size_t CTL_CNT  = 16384;
constexpr size_t CTL_ZERO_BYTES = 20480;
constexpr size_t WS_WQKV  = AL(WS_CTL + CTL_ZERO_BYTES);
constexpr size_t WS_WO    = AL(WS_WQKV + (size_t)2 * 6144 * 2048 * 2);
constexpr size_t WS_WPOOL = AL(WS_WO + (size_t)2 * 2048 * 2048 * 2);
constexpr size_t WS_WIN   = AL(WS_WPOOL + (size_t)8 * 512 * 512 * 2);
constexpr size_t WS_WOUT  = AL(WS_WIN + (size_t)256 * 1024 * 2048 * 2);
constexpr size_t WS_ROPE  = AL(WS_WOUT + (size_t)256 * 2048 * 512 * 2);
constexpr size_t WS_H     = AL(WS_ROPE + (size_t)S * 32 * 4);
constexpr size_t WS_HB    = AL(WS_H + (size_t)S * D * 4);
constexpr size_t WS_Q     = AL(WS_HB + (size_t)S * D * 2);
constexpr size_t WS_K     = AL(WS_Q + (size_t)S * D * 2);
constexpr size_t WS_V     = AL(WS_K + (size_t)S * D * 2);
constexpr size_t WS_AO    = AL(WS_V + (size_t)S * D * 2);
constexpr size_t WS_Z     = AL(WS_AO + (size_t)S * D * 2);
constexpr size_t WS_H1    = AL(WS_Z + (size_t)S * D * 4);
constexpr size_t WS_H1B   = AL(WS_H1 + (size_t)S * D * 4);
constexpr size_t WS_HACT  = AL(WS_H1B + (size_t)S * D * 2);
constexpr size_t WS_Y     = AL(WS_HACT + (size_t)(2 * S + 256) * DFF * 2);
constexpr size_t WS_SEG   = AL(WS_Y + (size_t)2 * S * D * 2);
constexpr size_t WS_GATE  = AL(WS_SEG + (size_t)NE * SEGCAP * 4);
constexpr size_t WS_OSCR  = AL(WS_GATE + (size_t)2 * S * 4);
constexpr size_t WS_RT    = AL(WS_OSCR + (size_t)256 * 512 * 128 * 4);
constexpr size_t WS_END   = AL(WS_RT + (size_t)2 * NE * D * 2);
static_assert(WS_V - WS_K == WS_K - WS_Q, "q|k|v spacing");
static_assert(WS_END < 0xFFFFFFFFull, "workspace offsets must fit 32 bits (buffer addressing)");

constexpr int LDS_BYTES = 147456;
constexpr int LDS_MISC  = 131072;

__device__ __forceinline__ unsigned cvtpk(float lo, float hi) { unsigned r; asm volatile("v_cvt_pk_bf16_f32 %0, %1, %2" : "=v"(r) : "v"(lo), "v"(hi)); return r; }
#define SWZ_ADD(v, pat) v += __int_as_float(__builtin_amdgcn_ds_swizzle(__float_as_int(v), pat))
__device__ __forceinline__ float wave_sum(float v) {
    SWZ_ADD(v, 0x041F); SWZ_ADD(v, 0x081F); SWZ_ADD(v, 0x101F); SWZ_ADD(v, 0x201F); SWZ_ADD(v, 0x401F);
    auto rr = __builtin_amdgcn_permlane32_swap(__float_as_uint(v), __float_as_uint(v), false, false);
    return __uint_as_float(rr[0]) + __uint_as_float(rr[1]);
}
template <class T> __device__ __forceinline__ T* as_global(T* p) { return (T*)(__attribute__((address_space(1))) T*)p; }
#define VM_WAIT0() asm volatile("s_waitcnt vmcnt(0)" ::: "memory")
#define LGKM_WAIT0() asm volatile("s_waitcnt lgkmcnt(0)" ::: "memory")
#define SBAR() __builtin_amdgcn_sched_barrier(0)
__device__ __forceinline__ int phase_tid_w(int wv) { unsigned all = ~0u; asm volatile("" : "+s"(all)); return wv * 64 + (int)__builtin_amdgcn_mbcnt_hi(all, __builtin_amdgcn_mbcnt_lo(all, 0u)); }
#define phase_tid() phase_tid_w(F.wv)

#define XB_TMO      128
#define XB_XCNT(j)  (256  + 64 * (j))
#define XB_XSUB(j)  (1280 + 64 * (j))
#define XB_XGEN(j)  (2304 + 64 * (j))
#define XB_TOP      3328
#define XB_TOPGEN   3392
#define XCD_BAR_WORDS 3456
#define XB_SPIN_CAP (1u << 18)

__device__ __forceinline__ unsigned xb_ld(unsigned* p)              { return __hip_atomic_load(p, __ATOMIC_RELAXED, __HIP_MEMORY_SCOPE_AGENT); }
__device__ __forceinline__ unsigned xb_add(unsigned* p, unsigned v) { return __hip_atomic_fetch_add(p, v, __ATOMIC_RELAXED, __HIP_MEMORY_SCOPE_AGENT); }
__device__ __forceinline__ unsigned xb_xcc_id() { return (unsigned)__builtin_amdgcn_s_getreg((3 << 11) | 20) & 0xFu; }
#define XB_SPIN(cond, bar) do { unsigned _sp = 0; while (cond) { __builtin_amdgcn_s_sleep(1); \
    if ((++_sp & 255u) == 0u) { if (xb_ld(&(bar)[XB_TMO])) break; if (_sp > XB_SPIN_CAP) { atomicAdd(&(bar)[XB_TMO], 1u); break; } } } } while (0)

struct XcdBarrier { unsigned* bar; unsigned x; volatile LAS unsigned* st; };

__device__ __forceinline__ XcdBarrier xcd_barrier_post(unsigned* bar, volatile LAS unsigned* st) {
    XcdBarrier b; b.bar = bar; b.x = xb_xcc_id(); b.st = st;
    if (threadIdx.x == 0) (void)xb_add(&bar[XB_XCNT(b.x)], 1u);
    return b;
}
__device__ __forceinline__ void xcd_barrier_complete(unsigned* bar, unsigned x, unsigned& nloc, unsigned& nx) {
    const unsigned G = gridDim.x * gridDim.y * gridDim.z;
    unsigned sum, cnt, mine, sp = 0u;
    for (;;) {
        sum = 0u; cnt = 0u;
#pragma unroll 1
        for (unsigned j = 0; j < 16; ++j) { const unsigned c = xb_ld(&bar[XB_XCNT(j)]); sum += c; cnt += (c > 0u) ? 1u : 0u; }
        mine = xb_ld(&bar[XB_XCNT(x)]);
        if (sum == G) break;
        __builtin_amdgcn_s_sleep(1);
        if ((++sp & 255u) == 0u) { if (xb_ld(&bar[XB_TMO])) break; if (sp > XB_SPIN_CAP) { atomicAdd(&bar[XB_TMO], 1u); break; } }
    }
    nloc = mine > 0u ? mine : 1u; nx = cnt > 0u ? cnt : 1u;
}
__device__ __forceinline__ void xcd_barrier(const XcdBarrier& b) {
    asm volatile("s_waitcnt vmcnt(0)" ::: "memory");
    __syncthreads();
    if (threadIdx.x == 0) {
        unsigned* bar; { size_t z = 0; asm volatile("" : "+s"(z)); bar = as_global(b.bar) + z; }
        __builtin_amdgcn_s_waitcnt(0);
        unsigned nloc = b.st[0], nx = b.st[1];
        if (nloc == 0u) { xcd_barrier_complete(bar, b.x, nloc, nx); b.st[0] = nloc; b.st[1] = nx; }
        const unsigned old = xb_add(&bar[XB_XSUB(b.x)], 1u);
        const unsigned gen = old / nloc;
        if (old + 1u == (gen + 1u) * nloc) {
            __builtin_amdgcn_fence(__ATOMIC_RELEASE, "agent");
            asm volatile("s_waitcnt vmcnt(0)" ::: "memory");
            const unsigned og = xb_add(&bar[XB_TOP], 1u);
            const unsigned tg = og / nx;
            if (og + 1u == (tg + 1u) * nx) xb_add(&bar[XB_TOPGEN], 1u);
            else XB_SPIN(xb_ld(&bar[XB_TOPGEN]) == tg, bar);
            __builtin_amdgcn_fence(__ATOMIC_ACQUIRE, "agent");
            xb_add(&bar[XB_XGEN(b.x)], 1u);
            asm volatile("s_waitcnt vmcnt(0)" ::: "memory");
        } else {
            XB_SPIN(xb_ld(&bar[XB_XGEN(b.x)]) == gen, bar);
            __builtin_amdgcn_fence(__ATOMIC_ACQUIRE, "agent");
            asm volatile("s_waitcnt vmcnt(0)" ::: "memory");
        }
    }
    __syncthreads();
}

namespace pg8 {
constexpr int BM = 256, BK = 64, HALF = 128, HTB = HALF * BK * 2, STAGE_BYTES = 8 * HTB;
__device__ __forceinline__ int lds_byte(int r, int c) { const int st = (r >> 4) * 2 + (c >> 5), rr = r & 15, cc = c & 31, ob = rr * 64 + cc * 2; return st * 1024 + (ob ^ (((ob >> 9) & 1) << 5)); }
__device__ __forceinline__ void stage_rc(int b, int& R, int& C) { const int st = b / 1024, sb = b % 1024, swz = sb ^ (((sb >> 9) & 1) << 5); R = (st >> 1) * 16 + swz / 64; C = (st & 1) * 32 + (swz % 64) / 2; }

struct GUnit { const char* A; const char* B; const int* list; int nvalid; int r0; int c0; int aux; int pad; };

template <class Epi, class Sched, bool GATHER>
__device__ __forceinline__ void gemm_phase(LAS unsigned char* lds, const int wv, const int K, const int lda, const int ldb, const Sched& Sch, const Epi& E) {
    const int tid = phase_tid_w(wv), wid = __builtin_amdgcn_readfirstlane(tid >> 6), lane = tid & 63, wr = wid >> 2, wc = wid & 3, fr = lane & 15, fq = lane >> 4;
    const int nt = K / BK;
    int stR[2], stC[2];
    unsigned voffA[2], voffB[2];
#pragma unroll
    for (int i = 0; i < 2; ++i) { stage_rc(tid * 16 + i * 8192, stR[i], stC[i]);
        voffA[i] = (unsigned)(stR[i] * lda + stC[i]) * 2u; voffB[i] = (unsigned)(stR[i] * ldb + stC[i]) * 2u; }
    unsigned vgc[2][2], vgn[2][2];
    const size_t kstep = (size_t)(BK * 2);
    const size_t hstepA = (size_t)HALF * lda * 2, hstepB = (size_t)HALF * ldb * 2;
    const unsigned ldsw = (unsigned)wid * 1024u;
    const int aoff = lds_byte(wr * 64 + fr, fq * 8), boff = lds_byte(wc * 32 + fr, fq * 8);
#define PG8_SA(b, h) (((b) * 2 + (h)) * HTB)
#define PG8_SB(b, h) ((4 + (b) * 2 + (h)) * HTB)
#define PG8_RAW(bufoff, p0, p1) do { \
        __builtin_amdgcn_global_load_lds((const unsigned*)(p0), (LAS unsigned*)(lds + (bufoff) + ldsw), 16, 0, 0); \
        __builtin_amdgcn_global_load_lds((const unsigned*)(p1), (LAS unsigned*)(lds + (bufoff) + ldsw + 8192), 16, 0, 0); } while (0)
#define PG8_STB(bufoff, gbase) PG8_RAW(bufoff, (gbase) + voffB[0], (gbase) + voffB[1])
#define PG8_STA(bufoff, gbase, h, nx) do { if constexpr (GATHER) { const unsigned _o0 = (nx) ? vgn[h][0] : vgc[h][0], _o1 = (nx) ? vgn[h][1] : vgc[h][1]; PG8_RAW(bufoff, (gbase) + _o0, (gbase) + _o1); } \
        else { PG8_RAW(bufoff, (gbase) + (h) * hstepA + voffA[0], (gbase) + (h) * hstepA + voffA[1]); } } while (0)
#define PG8_LDA(dst, b, h) do { _Pragma("unroll") for (int m = 0; m < 4; ++m) _Pragma("unroll") for (int k = 0; k < 2; ++k) dst[m][k] = *(const LAS bf16x8*)(lds + PG8_SA(b, h) + aoff + m * 2048 + k * 1024); } while (0)
#define PG8_LDB(dst, b, h) do { _Pragma("unroll") for (int n = 0; n < 2; ++n) _Pragma("unroll") for (int k = 0; k < 2; ++k) dst[n][k] = *(const LAS bf16x8*)(lds + PG8_SB(b, h) + boff + n * 2048 + k * 1024); } while (0)
#define PG8_MMA(ai, bj, At, Bt) do { __builtin_amdgcn_s_setprio(1); _Pragma("unroll") for (int m = 0; m < 4; ++m) _Pragma("unroll") for (int n = 0; n < 2; ++n) _Pragma("unroll") for (int k = 0; k < 2; ++k) \
        acc[ai][bj][m][n] = __builtin_amdgcn_mfma_f32_16x16x32_bf16(Bt[n][k], At[m][k], acc[ai][bj][m][n], 0, 0, 0); \
        if (PROBE_GMFMA) { bf16x8 zz = {0, 0, 0, 0, 0, 0, 0, 0}; asm volatile("" : "+v"(zz)); _Pragma("unroll") for (int m = 0; m < 4; ++m) acc[ai][bj][m][0] = __builtin_amdgcn_mfma_f32_16x16x32_bf16(zz, At[m][0], acc[ai][bj][m][0], 0, 0, 0); } \
        __builtin_amdgcn_s_setprio(0); } while (0)
#define PG8_WAIT_V(n) asm volatile("s_waitcnt vmcnt(" #n ")" ::: "memory")
#define PG8_WAIT_L(n) asm volatile("s_waitcnt lgkmcnt(" #n ")" ::: "memory")
#define PG8_BAR __builtin_amdgcn_s_barrier()
#define PG8_SCHED __builtin_amdgcn_sched_barrier(0)
#define PG8_GOFF(dst, u) do { _Pragma("unroll") for (int h = 0; h < 2; ++h) _Pragma("unroll") for (int i = 0; i < 2; ++i) { \
        const int rr = h * HALF + stR[i]; const int sl = (u).list[rr < (u).nvalid ? rr : 0]; dst[h][i] = (unsigned)((sl >> 1) * lda + stC[i]) * 2u; } } while (0)
    GUnit cur, nxt; int ui = 0;
    if (!Sch.next(0, cur)) return;
    f32x4 acc[2][2][4][2];
#pragma unroll
    for (int a = 0; a < 2; ++a)
#pragma unroll
        for (int b = 0; b < 2; ++b)
#pragma unroll
            for (int m = 0; m < 4; ++m)
#pragma unroll
                for (int n = 0; n < 2; ++n) acc[a][b][m][n] = (f32x4){0.f, 0.f, 0.f, 0.f};
    bf16x8 At[4][2], B0[2][2], B1[2][2];
    const char* cA = cur.A; const char* cB = cur.B;
    if constexpr (GATHER) { PG8_GOFF(vgc, cur); }
    PG8_STB(PG8_SB(0, 0), cB); PG8_STA(PG8_SA(0, 0), cA, 0, false); PG8_STB(PG8_SB(0, 1), cB + hstepB); PG8_STA(PG8_SA(0, 1), cA, 1, false);
    if (wr == 1) PG8_BAR;
    PG8_WAIT_V(4); PG8_BAR;
    PG8_STB(PG8_SB(1, 0), cB + kstep); PG8_STA(PG8_SA(1, 0), cA + kstep, 0, false); PG8_STB(PG8_SB(1, 1), cB + hstepB + kstep);
    PG8_WAIT_V(6); PG8_BAR;
    for (;;) {
        const bool has_next = Sch.next(ui + 1, nxt);
        const char* nA = has_next ? nxt.A : cA; const char* nB = has_next ? nxt.B : cB;
        if constexpr (GATHER) {
            if (has_next) { PG8_GOFF(vgn, nxt); }
            else {
#pragma unroll
                for (int h = 0; h < 2; ++h)
#pragma unroll
                    for (int i = 0; i < 2; ++i) vgn[h][i] = vgc[h][i]; }
        }
        for (int t = 0; t < nt; t += 2) {
            const bool last = (t == nt - 2);
            const char* a1 = cA + (size_t)(t + 1) * kstep;
            const char* a2 = last ? nA : cA + (size_t)(t + 2) * kstep; const char* b2 = last ? nB : cB + (size_t)(t + 2) * kstep;
            const char* a3 = a2 + kstep; const char* b3 = b2 + kstep;
            PG8_LDB(B0, 0, 0); PG8_SCHED; PG8_LDA(At, 0, 0); PG8_STA(PG8_SA(1, 1), a1, 1, false);
            PG8_WAIT_L(8); PG8_BAR; PG8_WAIT_L(0); PG8_MMA(0, 0, At, B0); PG8_BAR; PG8_SCHED;
            PG8_LDB(B1, 0, 1); PG8_STB(PG8_SB(0, 0), b2);
            PG8_BAR; PG8_WAIT_L(0); PG8_MMA(0, 1, At, B1); PG8_BAR;
            PG8_LDA(At, 0, 1); PG8_STA(PG8_SA(0, 0), a2, 0, last);
            PG8_BAR; PG8_WAIT_L(0); PG8_MMA(1, 0, At, B0); PG8_BAR; PG8_SCHED;
            PG8_STB(PG8_SB(0, 1), b2 + hstepB);
            PG8_WAIT_V(6); PG8_BAR; PG8_MMA(1, 1, At, B1); PG8_BAR;
            PG8_LDB(B0, 1, 0); PG8_SCHED; PG8_LDA(At, 1, 0); PG8_STA(PG8_SA(0, 1), a2, 1, last);
            PG8_WAIT_L(8); PG8_BAR; PG8_WAIT_L(0); PG8_MMA(0, 0, At, B0); PG8_BAR; PG8_SCHED;
            PG8_LDB(B1, 1, 1); PG8_STB(PG8_SB(1, 0), b3);
            PG8_BAR; PG8_WAIT_L(0); PG8_MMA(0, 1, At, B1); PG8_BAR;
            PG8_LDA(At, 1, 1); PG8_STA(PG8_SA(1, 0), a3, 0, last);
            PG8_BAR; PG8_WAIT_L(0); PG8_MMA(1, 0, At, B0); PG8_BAR; PG8_SCHED;
            PG8_STB(PG8_SB(1, 1), b3 + hstepB);
            PG8_WAIT_V(6); PG8_BAR; PG8_MMA(1, 1, At, B1); PG8_BAR;
        }
        E(acc, cur, wr, wc, fr, fq);
        if (!has_next) break;
#pragma unroll
        for (int a = 0; a < 2; ++a)
#pragma unroll
            for (int b = 0; b < 2; ++b)
#pragma unroll
                for (int m = 0; m < 4; ++m)
#pragma unroll
                    for (int n = 0; n < 2; ++n) acc[a][b][m][n] = (f32x4){0.f, 0.f, 0.f, 0.f};
        cur = nxt; cA = nA; cB = nB; ++ui;
        if constexpr (GATHER) {
#pragma unroll
            for (int h = 0; h < 2; ++h)
#pragma unroll
                for (int i = 0; i < 2; ++i) vgc[h][i] = vgn[h][i]; }
    }
    PG8_WAIT_V(0);
    if (wr == 0) PG8_BAR;
    PG8_BAR;
#undef PG8_SA
#undef PG8_SB
#undef PG8_RAW
#undef PG8_STB
#undef PG8_STA
#undef PG8_LDA
#undef PG8_LDB
#undef PG8_MMA
#undef PG8_WAIT_V
#undef PG8_WAIT_L
#undef PG8_BAR
#undef PG8_SCHED
#undef PG8_GOFF
}

struct DenseOrder {
    const char* A; const char* B; int lda, ldb; int nM, nN, nwg, G, c;
    __device__ __forceinline__ void init(const void* A_, const void* B_, int lda_, int ldb_, int M, int N, int G_, int c_) { A = (const char*)A_; B = (const char*)B_; lda = lda_; ldb = ldb_; nM = M / BM; nN = N / BM; nwg = nM * nN; G = G_; c = c_; }
    __device__ __forceinline__ bool next(int i, GUnit& u) const {
        const long L = (long)i * G + c; if (L >= nwg) return false;
        int wgid = (int)L; { const int q = nwg / 8, r = nwg % 8, xcd = wgid % 8, off = wgid / 8; wgid = (xcd < r ? xcd * (q + 1) : r * (q + 1) + (xcd - r) * q) + off; }
        const int nig = 8 * nN, gid = wgid / nig, fm = gid * 8, gsz = (nM - fm) < 8 ? (nM - fm) : 8;
        const int pm = fm + ((wgid % nig) % gsz), pn = (wgid % nig) / gsz;
        u.A = A + (size_t)pm * BM * lda * 2; u.B = B + (size_t)pn * BM * ldb * 2; u.list = nullptr; u.nvalid = 256; u.r0 = pm * BM; u.c0 = pn * BM; u.aux = 0; u.pad = 0; return true;
    }
};
struct PoolOrder {
    const char* A; const char* B; int G, c;
    __device__ __forceinline__ bool next(int i, GUnit& u) const {
        const int L = i * G + c; if (L >= 512) return false;
        const int g = L >> 7, pm = (L & 127) >> 1, pn = L & 1;
        u.A = A + ((size_t)pm * BM * D + (size_t)g * 512) * 2; u.B = B + ((size_t)g * 512 * 512 + (size_t)pn * BM * 512) * 2;
        u.list = nullptr; u.nvalid = 256; u.r0 = pm * BM; u.c0 = g * 512 + pn * BM; u.aux = g; u.pad = 0; return true;
    }
};
struct MoeOrder {
    const LAS int* tab; const char* A; const char* B; const int* seg; int nN, G, c, mode; size_t bstride;
    __device__ __forceinline__ bool next(int i, GUnit& u) const {
        const int cx = (G % 8 == 0) ? (c % 8) * (G / 8) + c / 8 : c;
        const int L = i * G + cx; const int ntile = tab[64 + 64];
        if (L >= ntile * nN) return false;
        const int rtg = L / nN, pn = L % nN;
        int e = 0;
#pragma unroll 1
        for (int j = 32; j >= 1; j >>= 1) if (tab[64 + e + j] <= rtg) e += j;
        const int rt = rtg - tab[64 + e], cnt = tab[e], roff = tab[129 + e];
        u.nvalid = (cnt - rt * BM) < BM ? (cnt - rt * BM) : BM;
        u.list = seg + (size_t)e * SEGCAP + rt * BM;
        u.r0 = roff + rt * BM; u.c0 = pn * BM; u.aux = e; u.pad = 0;
        u.B = B + (size_t)e * bstride + (size_t)pn * BM * (mode == 0 ? D : DFF) * 2;
        u.A = mode == 0 ? A : A + (size_t)(roff + rt * BM) * DFF * 2;
        return true;
    }
};

struct EpiQKV {
    bf16_t* Q; const float* rope;
    __device__ __forceinline__ void operator()(const f32x4 (&acc)[2][2][4][2], const GUnit& u, int wr, int wc, int fr, int fq) const {
        const int region = u.c0 >> 11; bf16_t* base = Q + (size_t)region * ((WS_K - WS_Q) / 2);
        const int col0 = (u.c0 & 2047) + wc * 32 + 4 * fq; const bool rot = (region < 2) && (wc == 0);
        const float qs = region == 0 ? 0.12751743074602334f : 1.0f;
        f32x4 cs[2][4], sn[2][4];
#pragma unroll
        for (int ai = 0; ai < 2; ++ai)
#pragma unroll
            for (int m = 0; m < 4; ++m) { cs[ai][m] = (f32x4){1.f, 1.f, 1.f, 1.f}; sn[ai][m] = (f32x4){0.f, 0.f, 0.f, 0.f}; }
        if (rot) {
#pragma unroll
            for (int ai = 0; ai < 2; ++ai)
#pragma unroll
                for (int m = 0; m < 4; ++m) { const int row = u.r0 + ai * HALF + wr * 64 + m * 16 + fr;
                    cs[ai][m] = *(const f32x4*)(rope + (size_t)row * 32 + 4 * fq); sn[ai][m] = *(const f32x4*)(rope + (size_t)row * 32 + 16 + 4 * fq); }
        }
#pragma unroll
        for (int ai = 0; ai < 2; ++ai)
#pragma unroll
            for (int m = 0; m < 4; ++m) {
                const int row = u.r0 + ai * HALF + wr * 64 + m * 16 + fr;
                bf16_t* rowp = base + (size_t)row * D + col0;
#pragma unroll
                for (int bj = 0; bj < 2; ++bj) {
                    const f32x4 v0 = acc[ai][bj][m][0], v1 = acc[ai][bj][m][1];
                    const f32x4 o0 = (v0 * cs[ai][m] - v1 * sn[ai][m]) * qs, o1 = (v1 * cs[ai][m] + v0 * sn[ai][m]) * qs;
                    u32x2 w0, w1; w0.x = cvtpk(o0[0], o0[1]); w0.y = cvtpk(o0[2], o0[3]); w1.x = cvtpk(o1[0], o1[1]); w1.y = cvtpk(o1[2], o1[3]);
                    *(u32x2*)(rowp + bj * HALF) = w0; *(u32x2*)(rowp + bj * HALF + 16) = w1; }
            }
    }
};
struct EpiMix {
    bf16_t* M; const float* scale;
    __device__ __forceinline__ void operator()(const f32x4 (&acc)[2][2][4][2], const GUnit& u, int wr, int wc, int fr, int fq) const {
        const int col0 = u.c0 + wc * 32 + 4 * fq;
        f32x4 sc[2][2];
#pragma unroll
        for (int bj = 0; bj < 2; ++bj)
#pragma unroll
            for (int n = 0; n < 2; ++n) sc[bj][n] = scale ? *(const f32x4*)(scale + col0 + bj * HALF + n * 16) : (f32x4){1.f, 1.f, 1.f, 1.f};
#pragma unroll
        for (int ai = 0; ai < 2; ++ai)
#pragma unroll
            for (int m = 0; m < 4; ++m) { bf16_t* rowp = M + (size_t)(u.r0 + ai * HALF + wr * 64 + m * 16 + fr) * D + col0;
#pragma unroll
                for (int bj = 0; bj < 2; ++bj)
#pragma unroll
                    for (int n = 0; n < 2; ++n) { const f32x4 o = acc[ai][bj][m][n] * sc[bj][n]; u32x2 w; w.x = cvtpk(o[0], o[1]); w.y = cvtpk(o[2], o[3]); *(u32x2*)(rowp + bj * HALF + n * 16) = w; } }
    }
};
struct EpiMoeIn {
    bf16_t* H;
    __device__ __forceinline__ void operator()(const f32x4 (&acc)[2][2][4][2], const GUnit& u, int wr, int wc, int fr, int fq) const {
        const int col0 = (u.c0 >> 1) + wc * 32 + 4 * fq;
#pragma unroll
        for (int ai = 0; ai < 2; ++ai)
#pragma unroll
            for (int m = 0; m < 4; ++m) {
                const int r = ai * HALF + wr * 64 + m * 16 + fr;
                if (r < u.nvalid) {
                    bf16_t* rowp = H + (size_t)(u.r0 + r) * DFF + col0;
#pragma unroll
                    for (int n = 0; n < 2; ++n) { const f32x4 g = acc[ai][0][m][n], up = acc[ai][1][m][n]; f32x4 o;
#pragma unroll
                        for (int j = 0; j < 4; ++j) o[j] = g[j] * __builtin_amdgcn_rcpf(1.0f + __builtin_amdgcn_exp2f(-1.4426950408889634f * g[j])) * up[j];
                        u32x2 w; w.x = cvtpk(o[0], o[1]); w.y = cvtpk(o[2], o[3]); *(u32x2*)(rowp + n * 16) = w; }
                }
            }
    }
};
struct EpiMoeOut {
    bf16_t* Y; const float* gates;
    __device__ __forceinline__ void operator()(const f32x4 (&acc)[2][2][4][2], const GUnit& u, int wr, int wc, int fr, int fq) const {
        const int col0 = u.c0 + wc * 32 + 4 * fq;
        int slot[2][4]; float g[2][4];
#pragma unroll
        for (int ai = 0; ai < 2; ++ai)
#pragma unroll
            for (int m = 0; m < 4; ++m) { const int r = ai * HALF + wr * 64 + m * 16 + fr; slot[ai][m] = u.list[r < u.nvalid ? r : 0]; }
#pragma unroll
        for (int ai = 0; ai < 2; ++ai)
#pragma unroll
            for (int m = 0; m < 4; ++m) g[ai][m] = gates[slot[ai][m]];
#pragma unroll
        for (int ai = 0; ai < 2; ++ai)
#pragma unroll
            for (int m = 0; m < 4; ++m) {
                const int r = ai * HALF + wr * 64 + m * 16 + fr;
                if (r < u.nvalid) {
                    bf16_t* rowp = Y + (size_t)slot[ai][m] * D + col0;
#pragma unroll
                    for (int bj = 0; bj < 2; ++bj)
#pragma unroll
                        for (int n = 0; n < 2; ++n) { const f32x4 o = acc[ai][bj][m][n] * g[ai][m]; u32x2 w; w.x = cvtpk(o[0], o[1]); w.y = cvtpk(o[2], o[3]); *(u32x2*)(rowp + bj * HALF + n * 16) = w; }
                }
            }
    }
};
}

struct Args { const float* in[13]; float* out; unsigned char* ws; int ph_lo, ph_hi; };
struct Ctx { unsigned char* ws; LAS unsigned char* lds; int G, bid, wv; };
typedef const __attribute__((address_space(4))) Args* KArgs;
__device__ __forceinline__ KArgs kargs() { KArgs p = (KArgs)__builtin_amdgcn_kernarg_segment_ptr(); asm volatile("" : "+s"(p)); return p; }
__device__ __forceinline__ unsigned char* opaque_ws(unsigned char* p) { size_t z = 0; asm volatile("" : "+s"(z)); return as_global(p) + z; }
enum { IN_X = 0, IN_WQKV, IN_LAMBDA, IN_SUBLN, IN_WO, IN_POOLW, IN_POOLSC, IN_ROUTERW, IN_ROUTERB, IN_MOEIN, IN_MOEOUT, IN_LNG, IN_LNB };

constexpr int P0_QKV = 2 * 16 * 48, P0_WO = 2 * 16 * 16, P0_POOL = 8 * 4 * 4, P0_MIN = 256 * 16 * 8, P0_MOUT = 256 * 4 * 16;
__device__ __forceinline__ void p0_decode(int ur, unsigned char* ws, KArgs KA, const float*& src, bf16_t*& dst, int& ldn, int& K) {
    int u = (P0_QKV + P0_WO + P0_POOL + P0_MIN + P0_MOUT - 1) - ur;
    int mat, kt, ntile, n0s, n0d;
    if (u < P0_QKV) { mat = u / 768; const int r = u % 768; kt = r / 48; ntile = r % 48; ldn = 6144; K = 2048; n0s = n0d = ntile * 128;
        src = as_global(KA->in[IN_WQKV]) + (size_t)mat * 2048 * 6144; dst = (bf16_t*)(ws + WS_WQKV) + (size_t)mat * 6144 * 2048; }
    else if ((u -= P0_QKV) < P0_WO) { mat = u / 256; const int r = u % 256; kt = r / 16; ntile = r % 16; ldn = 2048; K = 2048; n0s = n0d = ntile * 128;
        src = as_global(KA->in[IN_WO]) + (size_t)mat * 2048 * 2048; dst = (bf16_t*)(ws + WS_WO) + (size_t)mat * 2048 * 2048; }
    else if ((u -= P0_WO) < P0_POOL) { mat = u / 16; const int r = u % 16; kt = r / 4; ntile = r % 4; ldn = 512; K = 512; n0s = n0d = ntile * 128;
        src = as_global(KA->in[IN_POOLW]) + (size_t)mat * 512 * 512; dst = (bf16_t*)(ws + WS_WPOOL) + (size_t)mat * 512 * 512; }
    else if ((u -= P0_POOL) < P0_MIN) { mat = u / 128; const int r = u % 128; kt = r / 8; ntile = r % 8; ldn = 1024; K = 2048; n0s = ntile * 128;
        { const int bj = n0s >> 9, pn = (n0s & 511) >> 7; n0d = 256 * pn + 128 * bj; }
        src = as_global(KA->in[IN_MOEIN]) + (size_t)mat * 2048 * 1024; dst = (bf16_t*)(ws + WS_WIN) + (size_t)mat * 1024 * 2048; }
    else { u -= P0_MIN; mat = u / 64; const int r = u % 64; kt = r / 16; ntile = r % 16; ldn = 2048; K = 512; n0s = n0d = ntile * 128;
        src = as_global(KA->in[IN_MOEOUT]) + (size_t)mat * 512 * 2048; dst = (bf16_t*)(ws + WS_WOUT) + (size_t)mat * 2048 * 512; }
    src += (size_t)kt * 128 * ldn + n0s; dst += (size_t)n0d * K + kt * 128;
}
constexpr int P0_UNITS = P0_QKV + P0_WO + P0_POOL + P0_MIN + P0_MOUT;
__device__ __forceinline__ void sincos_d(double a, double& s, double& c) {
    const double k = rint(a * 0.63661977236758134308);
    double r = fma(-k, 1.57079632679489655800e+00, a); r = fma(-k, 6.12323399573676603587e-17, r);
    const double r2 = r * r;
    double sp = r2 * (1.0 / 6227020800.0) - 1.0 / 39916800.0; sp = sp * r2 + 1.0 / 362880.0; sp = sp * r2 - 1.0 / 5040.0; sp = sp * r2 + 1.0 / 120.0; sp = sp * r2 - 1.0 / 6.0; sp = sp * r2 * r + r;
    double cp = r2 * (-1.0 / 87178291200.0) + 1.0 / 479001600.0; cp = cp * r2 - 1.0 / 3628800.0; cp = cp * r2 + 1.0 / 40320.0; cp = cp * r2 - 1.0 / 720.0; cp = cp * r2 + 1.0 / 24.0; cp = cp * r2 - 0.5; cp = cp * r2 + 1.0;
    const int q = ((int)k) & 3;
    s = (q == 0) ? sp : (q == 1) ? cp : (q == 2) ? -sp : -cp;
    c = (q == 0) ? cp : (q == 1) ? -sp : (q == 2) ? -cp : sp;
}
__device__ __forceinline__ void p0_convert(const Ctx& F, unsigned char* ws, KArgs KA, int tid, int u_begin, int u_end) {
    LAS unsigned short* T = (LAS unsigned short*)F.lds;
    constexpr int TP = 130;
    const int kr = tid >> 5, nc = (tid & 31) * 4;
    const int on = tid >> 2, ok = (tid & 3) * 32;
    int u = u_begin + F.bid;
    f32x4 v[8];
    const float* src; bf16_t* dst; int ldn, K;
    if (u < u_end) { p0_decode(u, ws, KA, src, dst, ldn, K);
#pragma unroll
        for (int i = 0; i < 8; ++i) v[i] = *(const f32x4*)(src + (size_t)(kr + 16 * i) * ldn + nc); }
    while (u < u_end) {
#pragma unroll
        for (int i = 0; i < 8; ++i) { const int k = kr + 16 * i;
            const unsigned p0 = cvtpk(v[i][0], v[i][1]), p1 = cvtpk(v[i][2], v[i][3]);
            T[(nc + 0) * TP + k] = (unsigned short)(p0 & 0xffff); T[(nc + 1) * TP + k] = (unsigned short)(p0 >> 16);
            T[(nc + 2) * TP + k] = (unsigned short)(p1 & 0xffff); T[(nc + 3) * TP + k] = (unsigned short)(p1 >> 16); }
        bf16_t* cdst = dst; const int cK = K;
        const int un = u + F.G;
        if (un < u_end) { p0_decode(un, ws, KA, src, dst, ldn, K);
#pragma unroll
            for (int i = 0; i < 8; ++i) v[i] = *(const f32x4*)(src + (size_t)(kr + 16 * i) * ldn + nc); }
        __syncthreads();
        { unsigned w[16];
#pragma unroll
          for (int j = 0; j < 16; ++j) w[j] = *(const LAS unsigned*)(T + on * TP + ok + 2 * j);
#pragma unroll
          for (int q = 0; q < 4; ++q) { u32x4 ww = {w[4 * q], w[4 * q + 1], w[4 * q + 2], w[4 * q + 3]}; *(u32x4*)(cdst + (size_t)on * cK + ok + 8 * q) = ww; } }
        __syncthreads();
        u = un;
    }
}
__device__ __forceinline__ void phase_prologue(const Ctx& F) {
    unsigned char* const ws = opaque_ws(F.ws);
    const int tid = phase_tid(); KArgs KA = kargs();
    constexpr int N_MOE_UNITS = P0_MIN + P0_MOUT;
    if (F.G != 256) p0_convert(F, ws, KA, tid, 0, N_MOE_UNITS);
    for (int e = F.bid * NTHREADS + tid; e < S * 16; e += F.G * NTHREADS) {
        const int pos = e >> 4, i = e & 15;
        const float invf = (float)exp2(-(double)i * (18.931568569324174087 / 16.0));
        const float ang = (float)pos * invf;
        double s, c; sincos_d((double)ang, s, c);
        float* rp = (float*)(ws + WS_ROPE) + (size_t)pos * 32; rp[i] = (float)c; rp[16 + i] = (float)s;
    }
    { const float* x = as_global(KA->in[IN_X]); bf16_t* hb = (bf16_t*)(ws + WS_HB);
      for (size_t i = (size_t)F.bid * NTHREADS + tid; i < (size_t)S * D / 8; i += (size_t)F.G * NTHREADS) {
          const f32x4 a = *(const f32x4*)(x + i * 8), b = *(const f32x4*)(x + i * 8 + 4);
          u32x4 w; w.x = cvtpk(a[0], a[1]); w.y = cvtpk(a[2], a[3]); w.z = cvtpk(b[0], b[1]); w.w = cvtpk(b[2], b[3]);
          *(u32x4*)(hb + i * 8) = w; } }
    { const float* rw = as_global(KA->in[IN_ROUTERW]); bf16_t* rth = (bf16_t*)(ws + WS_RT); bf16_t* rtl = rth + NE * D;
      for (int i = F.bid * NTHREADS + tid; i < D * NE; i += F.G * NTHREADS) { const int k = i >> 6, e = i & 63; const float x = rw[i];
          const unsigned h = cvtpk(x, 0.f) & 0xffffu; const float r = x - __uint_as_float(h << 16); const unsigned l = cvtpk(r, 0.f) & 0xffffu;
          rth[e * D + k] = (bf16_t)h; rtl[e * D + k] = (bf16_t)l; } }
    __syncthreads();
    p0_convert(F, ws, KA, tid, N_MOE_UNITS, P0_UNITS);
}

namespace att {
constexpr int KVBLK = 64;
constexpr int SHM_K = KVBLK * HD * 2  , SHM_V = KVBLK * VD * 2  ;
constexpr int OFF_K = 0, OFF_V = 2 * SHM_K;
#define KSWZ(row, colB) ((row) * 256 + ((colB) ^ (((row) & 15) << 4)))
__device__ __forceinline__ int crow(int r, int hi) { return (r & 3) + 8 * (r >> 2) + 4 * hi; }
__device__ __forceinline__ int v_st(int k, int c) { const int kk = (k & ~0xC) | ((k & 4) << 1) | ((k & 8) >> 1); return ((kk >> 3) * 8 + (c >> 5)) * 512 + ((kk & 7) * 32 + (c & 31)) * 2; }
__device__ __forceinline__ int v_rd_base(int lane) { return ((lane & 3) << 3) | (((lane >> 2) & 3) << 6) | (((lane >> 4) & 1) << 5) | (((lane >> 5) & 1) << 8); }
constexpr int v_rd_off(int d0, int ks, int half) { return d0 * 512 + ks * 8192 + half * 4096; }
template <int OFF> __device__ __forceinline__ s16x4 tr_read(int vb) {
    s16x4 r; asm volatile("ds_read_b64_tr_b16 %0, %1 offset:%2" : "=&v"(r) : "v"(vb), "i"(OFF) : "memory"); return r;
}
template <int OFF> __device__ __forceinline__ bf16x8 lds_read128(int a) {
    bf16x8 r; asm volatile("ds_read_b128 %0, %1 offset:%2" : "=&v"(r) : "v"(a), "i"(OFF) : "memory"); return r;
}
template <int OFF> __device__ __forceinline__ void lds_write128(int a, u32x4 v) {
    asm volatile("ds_write_b128 %0, %1 offset:%2" :: "v"(a), "v"(v), "i"(OFF) : "memory");
}
#define PKV(L, H) (bf16x8){L[0], L[1], L[2], L[3], H[0], H[1], H[2], H[3]}
#define WAIT_LGKM(n) do { asm volatile("s_waitcnt lgkmcnt(" #n ")" ::: "memory"); SBAR(); } while (0)
#define PV_RD(R, D0, H) do { R##0 = tr_read<v_rd_off(D0, 2 * (H), 0)>(vb); R##1 = tr_read<v_rd_off(D0, 2 * (H), 1)>(vb); R##2 = tr_read<v_rd_off(D0, 2 * (H) + 1, 0)>(vb); R##3 = tr_read<v_rd_off(D0, 2 * (H) + 1, 1)>(vb); } while (0)
#define PV_MM(R, D0, PA, PB) do { o[D0] = __builtin_amdgcn_mfma_f32_32x32x16_bf16(PA, PKV(R##0, R##1), o[D0], 0, 0, 0); o[D0] = __builtin_amdgcn_mfma_f32_32x32x16_bf16(PB, PKV(R##2, R##3), o[D0], 0, 0, 0); SBAR(); } while (0)
template <int D_LO> __device__ __forceinline__ void pv_quad(f32x16 (&o)[8], int vb, const bf16x8& pa0, const bf16x8& pa1, const bf16x8& pa2, const bf16x8& pa3) {
    s16x4 A0, A1, A2, A3, B0, B1, B2, B3;
    PV_RD(A, D_LO + 0, 0); PV_RD(B, D_LO + 0, 1);
    WAIT_LGKM(4); PV_MM(A, D_LO + 0, pa0, pa1); PV_RD(A, D_LO + 1, 0);
    WAIT_LGKM(4); PV_MM(B, D_LO + 0, pa2, pa3); PV_RD(B, D_LO + 1, 1);
    WAIT_LGKM(4); PV_MM(A, D_LO + 1, pa0, pa1); PV_RD(A, D_LO + 2, 0);
    WAIT_LGKM(4); PV_MM(B, D_LO + 1, pa2, pa3); PV_RD(B, D_LO + 2, 1);
    WAIT_LGKM(4); PV_MM(A, D_LO + 2, pa0, pa1); PV_RD(A, D_LO + 3, 0);
    WAIT_LGKM(4); PV_MM(B, D_LO + 2, pa2, pa3); PV_RD(B, D_LO + 3, 1);
    WAIT_LGKM(4); PV_MM(A, D_LO + 3, pa0, pa1);
    WAIT_LGKM(0); PV_MM(B, D_LO + 3, pa2, pa3);
}
#define QK_RD(R, KB, DH) do { R##0 = lds_read128<(DH) * 128>(KB); R##1 = lds_read128<(DH) * 128 + 8192>(KB); } while (0)
#define QK_MM(R, Q) do { p0 = __builtin_amdgcn_mfma_f32_32x32x16_bf16(R##0, Q, p0, 0, 0, 0); p1 = __builtin_amdgcn_mfma_f32_32x32x16_bf16(R##1, Q, p1, 0, 0, 0); SBAR(); } while (0)
__device__ __forceinline__ void qk_tile(f32x16& p0, f32x16& p1, int k0, int k1, int k2, int k3, const bf16x8 (&qr)[8]) {
    bf16x8 A0, A1, B0, B1;
    QK_RD(A, k0, 0); QK_RD(B, k1, 0);
    WAIT_LGKM(2); QK_MM(A, qr[0]); QK_RD(A, k2, 0);
    WAIT_LGKM(2); QK_MM(B, qr[1]); QK_RD(B, k3, 0);
    WAIT_LGKM(2); QK_MM(A, qr[2]); QK_RD(A, k0 ^ 128, 0);
    WAIT_LGKM(2); QK_MM(B, qr[3]); QK_RD(B, k1 ^ 128, 0);
    WAIT_LGKM(2); QK_MM(A, qr[4]); QK_RD(A, k2 ^ 128, 0);
    WAIT_LGKM(2); QK_MM(B, qr[5]); QK_RD(B, k3 ^ 128, 0);
    WAIT_LGKM(2); QK_MM(A, qr[6]);
    WAIT_LGKM(0); QK_MM(B, qr[7]);
}
constexpr float THR_UP = 11.5f, THR_DN = 40.f;
__device__ __forceinline__ void softmax_tile(f32x16& p0, f32x16& p1, float& m_reg, float& l_reg, bool& mz, float& alpha, bf16x8& pa0, bf16x8& pa1, bf16x8& pa2, bf16x8& pa3) {
    float pmax = p0[0];
#pragma unroll
    for (int r = 1; r < 16; ++r) pmax = fmaxf(pmax, p0[r]);
#pragma unroll
    for (int r = 0; r < 16; ++r) pmax = fmaxf(pmax, p1[r]);
    { auto rr = __builtin_amdgcn_permlane32_swap(__float_as_uint(pmax), __float_as_uint(pmax), false, false);
      pmax = fmaxf(__uint_as_float(rr[0]), __uint_as_float(rr[1])); }
    const bool ok = (pmax <= THR_UP) && (pmax >= -THR_DN);
    alpha = 1.f;
    if (__builtin_expect(!__all(ok), 0)) {
        const float dlt = ok ? 0.f : fmaxf(pmax, -120.f);
        alpha = __builtin_amdgcn_exp2f(-dlt); m_reg += dlt; mz = __all(m_reg == 0.f);
#pragma unroll
        for (int r = 0; r < 16; ++r) { p0[r] -= dlt; p1[r] -= dlt; }
    }
#pragma unroll
    for (int r = 0; r < 16; ++r) { p0[r] = __builtin_amdgcn_exp2f(p0[r]); p1[r] = __builtin_amdgcn_exp2f(p1[r]); }
    float ps = 0;
#pragma unroll
    for (int r = 0; r < 16; ++r) ps += p0[r];
#pragma unroll
    for (int r = 0; r < 16; ++r) ps += p1[r];
    { auto rr = __builtin_amdgcn_permlane32_swap(__float_as_uint(ps), __float_as_uint(ps), false, false);
      ps = __uint_as_float(rr[0]) + __uint_as_float(rr[1]); }
    l_reg = l_reg * alpha + ps;
#define PK4(P, BASE, OUT) do { unsigned a0 = cvtpk(P[BASE + 0], P[BASE + 1]), a1 = cvtpk(P[BASE + 2], P[BASE + 3]);   \
    unsigned b0 = cvtpk(P[BASE + 4], P[BASE + 5]), b1 = cvtpk(P[BASE + 6], P[BASE + 7]);                              \
    auto r0 = __builtin_amdgcn_permlane32_swap(a0, b0, false, false); auto r1 = __builtin_amdgcn_permlane32_swap(a1, b1, false, false); \
    u32x4 w = {r0[0], r1[0], r0[1], r1[1]}; OUT = *reinterpret_cast<bf16x8*>(&w); } while (0)
    PK4(p0, 0, pa0); PK4(p0, 8, pa1); PK4(p1, 0, pa2); PK4(p1, 8, pa3);
#undef PK4
}

template <bool BG> __device__ __forceinline__ void attn_unit(const Ctx& F, const bf16_t* Qg, const bf16_t* Kg, const bf16_t* Vg, bf16_t* AO, const float* subg, float lam, float outscale, int h, int qb, int bgpass0) {
    unsigned char* const ws = opaque_ws(F.ws);
    const int ldsb = (int)(uintptr_t)F.lds;
    const int tid = phase_tid(), wid = __builtin_amdgcn_readfirstlane(tid >> 6), lane = tid & 63, r32 = lane & 31, hi = lane >> 5;
    const int grp = wid >> 2;
    LAS float* wsf = (LAS float*)(F.lds + LDS_MISC + 1024) + wid * 64;
    LAS float* li_l = wsf; LAS float* al_l = wsf + 32;
    constexpr int NT = S / KVBLK;
    const int ta = tid & 255;
    const __amdgpu_buffer_rsrc_t rW = __builtin_amdgcn_make_buffer_rsrc((void*)ws, 0, 0xFFFFFFFFu, 0x00020000);
    const int wK = ldsb + OFF_K + KSWZ(ta >> 4, (ta & 15) * 16);
    const int wV = ldsb + OFF_V + v_st(ta >> 5, (ta & 31) * 8);
    const int vrd = ldsb + OFF_V + v_rd_base(lane);
    const int x15 = (r32 & 15) << 4;
    for (int comp = 0; comp < 2; ++comp) {
        const int voQ = ((qb * 256 + wid * 32 + r32) * D + h * 256 + comp * 128 + hi * 8) * 2;
        const int voK = (((ta >> 4) * D) + h * 256 + comp * 128 + (ta & 15) * 8) * 2;
        const int voV = (((ta >> 5) * D) + h * 256 + (ta & 31) * 8) * 2;
        bf16x8 qr[8];
#pragma unroll
        for (int d0 = 0; d0 < 8; ++d0) { const u32x4 qv = __builtin_amdgcn_raw_buffer_load_b128(rW, voQ, (int)(unsigned)WS_Q + d0 * 32, 0); qr[d0] = *reinterpret_cast<const bf16x8*>(&qv); }
        f32x16 o[8];
#pragma unroll
        for (int d = 0; d < 8; ++d) o[d] = f32x16{};
        float m_reg = 0.f, l_reg = 0.f; bool mz = true;
        const int bgpass = bgpass0 + comp;
        const int bgm = !BG ? 0 : bgpass < 2 ? 1 : bgpass == 2 ? 2 : 0;
        const int bgN = bgm == 1 ? 1024 : 2048, bgK = bgm == 1 ? 2048 : 512;
        const float* bgsrc = as_global(kargs()->in[IN_MOEIN]); unsigned bgdst = 0;
        LAS unsigned char* const bgl = F.lds + 98304 + wid * 2048;
        if (bgm == 1) { const int n0 = (F.bid & 31) * 32, nd = 256 * ((n0 & 511) >> 7) + 128 * (n0 >> 9) + (n0 & 127);
            bgsrc = as_global(kargs()->in[IN_MOEIN]) + (size_t)bgpass * 256 * 1048576 + (F.bid >> 5) * 131072 + wid * 16384 + n0;
            bgdst = (unsigned)WS_WIN + (unsigned)bgpass * (128u * 2097152u * 2u) + (unsigned)(nd * 2048 + (F.bid >> 5) * 128 + wid * 16) * 2u; }
        else if (bgm == 2) { const int n0 = (F.bid & 63) * 32;
            bgsrc = as_global(kargs()->in[IN_MOEOUT]) + (F.bid >> 6) * (128 * 2048) + wid * (16 * 2048) + n0;
            bgdst = (unsigned)WS_WOUT + (unsigned)(n0 * 512 + (F.bid >> 6) * 128 + wid * 16) * 2u; }
        const unsigned long long bgp_ = (unsigned long long)(uintptr_t)bgsrc;
        const unsigned bgp0 = __builtin_amdgcn_readfirstlane((unsigned)bgp_), bgp1 = __builtin_amdgcn_readfirstlane((unsigned)(bgp_ >> 32)), bgnr = __builtin_amdgcn_readfirstlane(bgm ? 0xFFFFFFFFu : 0u);
#define BG_RSRC() __builtin_amdgcn_make_buffer_rsrc((void*)(uintptr_t)(((unsigned long long)(unsigned)__builtin_amdgcn_readfirstlane(bgp1) << 32) | (unsigned long long)(unsigned)__builtin_amdgcn_readfirstlane(bgp0)), 0, __builtin_amdgcn_readfirstlane(bgnr), 0x00020000)
#define BG_ISSUE(t) do { if constexpr (BG) { int lq = lane; asm volatile("" : "+v"(lq)); int lb_ = (int)(uintptr_t)bgl; asm volatile("" : "+s"(lb_)); \
            const int vo_ = ((lq >> 3) * bgN + 4 * (lq & 7)) * 4; const int so_ = (t) * 4194304; \
            const __amdgpu_buffer_rsrc_t rB_ = BG_RSRC(); \
            __builtin_amdgcn_raw_ptr_buffer_load_lds(rB_, (LAS void*)(uintptr_t)lb_, 16, vo_, so_, 0, 0); \
            __builtin_amdgcn_raw_ptr_buffer_load_lds(rB_, (LAS void*)(uintptr_t)(lb_ + 1024), 16, vo_, so_ + 32 * bgN, 0, 0); } } while (0)
#define BG_CONSUME(t) do { if constexpr (BG) { { int lq = lane; asm volatile("" : "+v"(lq)); \
            const LAS float* rp_ = (const LAS float*)(bgl + (lq >> 5) * 1024 + (lq & 31) * 4); \
            float x_[8]; _Pragma("unroll") for (int i_ = 0; i_ < 8; ++i_) x_[i_] = rp_[i_ * 32]; \
            u32x4 w_; w_.x = cvtpk(x_[0], x_[1]); w_.y = cvtpk(x_[2], x_[3]); w_.z = cvtpk(x_[4], x_[5]); w_.w = cvtpk(x_[6], x_[7]); \
            const int do_ = bgdst + (bgm == 1 ? ((t) >> 1) * 4194304 + ((t) & 1) * 2048 : (t) * 2097152); \
            const __amdgpu_buffer_rsrc_t rS_ = __builtin_amdgcn_make_buffer_rsrc((void*)(uintptr_t)(((unsigned long long)(unsigned)__builtin_amdgcn_readfirstlane(wsh_) << 32) | (unsigned long long)(unsigned)__builtin_amdgcn_readfirstlane(wsl_)), 0, __builtin_amdgcn_readfirstlane(bgnr), 0x00020000); \
            __builtin_amdgcn_raw_buffer_store_b128(w_, rS_, ((lq & 31) * bgK + (lq >> 5) * 8) * 2, do_, 0); SBAR(); } } } while (0)
        u32x4 st[3];
#define ST_LOAD0(t) do { const int sb = (t) * (KVBLK * D * 2); \
        if (grp == 0) { _Pragma("unroll") for (int i = 0; i < 3; ++i) st[i] = __builtin_amdgcn_raw_buffer_load_b128(rW, voK, (int)(unsigned)WS_K + sb + i * (16 * D * 2), 0); } \
        else { _Pragma("unroll") for (int i = 0; i < 3; ++i) st[i] = __builtin_amdgcn_raw_buffer_load_b128(rW, voV, (int)(unsigned)WS_V + sb + (i + 2) * (8 * D * 2), 0); } } while (0)
#define ST_LOAD1(t) do { const int sb = (t) * (KVBLK * D * 2); \
        if (grp == 0) { st[0] = __builtin_amdgcn_raw_buffer_load_b128(rW, voK, (int)(unsigned)WS_K + sb + 3 * (16 * D * 2), 0); \
                        st[1] = __builtin_amdgcn_raw_buffer_load_b128(rW, voV, (int)(unsigned)WS_V + sb, 0); st[2] = __builtin_amdgcn_raw_buffer_load_b128(rW, voV, (int)(unsigned)WS_V + sb + 8 * D * 2, 0); } \
        else { _Pragma("unroll") for (int i = 0; i < 3; ++i) st[i] = __builtin_amdgcn_raw_buffer_load_b128(rW, voV, (int)(unsigned)WS_V + sb + (i + 5) * (8 * D * 2), 0); } } while (0)
        const unsigned wsl_ = (unsigned)(uintptr_t)ws, wsh_ = (unsigned)((unsigned long long)(uintptr_t)ws >> 32);
#define ST_WRITE0(b) do { const int wk = wK + (b) * SHM_K, wv = wV + (b) * SHM_V; \
        if (grp == 0) { lds_write128<0>(wk, st[0]); lds_write128<4096>(wk, st[1]); lds_write128<8192>(wk, st[2]); } \
        else { lds_write128<8192>(wv, st[0]); lds_write128<8192 + 256>(wv, st[1]); lds_write128<16384>(wv, st[2]); } } while (0)
#define ST_WRITE1(b) do { const int wk = wK + (b) * SHM_K, wv = wV + (b) * SHM_V; \
        if (grp == 0) { lds_write128<12288>(wk, st[0]); lds_write128<0>(wv, st[1]); lds_write128<256>(wv, st[2]); } \
        else { lds_write128<16384 + 256>(wv, st[0]); lds_write128<24576>(wv, st[1]); lds_write128<24576 + 256>(wv, st[2]); } } while (0)
        { u32x4 keep0, keep1, keep2;
          ST_LOAD0(0); keep0 = st[0]; keep1 = st[1]; keep2 = st[2]; ST_LOAD1(0);
          { u32x4 t0 = st[0], t1 = st[1], t2 = st[2]; st[0] = keep0; st[1] = keep1; st[2] = keep2; ST_WRITE0(0); st[0] = t0; st[1] = t1; st[2] = t2; ST_WRITE1(0); } }
        LGKM_WAIT0(); __syncthreads();
        BG_ISSUE(0);
        if (grp == 1) __builtin_amdgcn_s_barrier();
#pragma unroll 1
        for (int t = 0; t < NT; ++t) {
            const int b = t & 1;
            const int tn = t + 1 < NT ? t + 1 : NT - 1;
            ST_LOAD0(tn);
            f32x16 p0 = f32x16{}, p1 = f32x16{}; float alpha; bf16x8 pa0, pa1, pa2, pa3;
            { const int kbuf = ldsb + OFF_K + b * SHM_K + r32 * 256;
              const int k0 = kbuf + ((0 * 32 + hi * 16) ^ x15), k1 = kbuf + ((1 * 32 + hi * 16) ^ x15), k2 = kbuf + ((2 * 32 + hi * 16) ^ x15), k3 = kbuf + ((3 * 32 + hi * 16) ^ x15);
              __builtin_amdgcn_s_setprio(2);
              if (mz) { qk_tile(p0, p1, k0, k1, k2, k3, qr); }
              else {
#pragma unroll
                  for (int r = 0; r < 16; ++r) { p0[r] = -m_reg; p1[r] = -m_reg; }
                  qk_tile(p0, p1, k0, k1, k2, k3, qr); }
              __builtin_amdgcn_s_setprio(0); }
            if constexpr (BG) { asm volatile("s_waitcnt vmcnt(3)" ::: "memory"); BG_CONSUME(t); }
            softmax_tile(p0, p1, m_reg, l_reg, mz, alpha, pa0, pa1, pa2, pa3);
            if (__any(alpha != 1.f)) { if (hi == 0) al_l[r32] = alpha; LGKM_WAIT0();
#pragma unroll
                for (int r = 0; r < 16; ++r) { const float a = al_l[crow(r, hi)];
#pragma unroll
                    for (int d = 0; d < 8; ++d) o[d][r] *= a; } }
            LGKM_WAIT0(); __builtin_amdgcn_s_barrier(); SBAR();
            const int vb = vrd + b * SHM_V;
            ST_WRITE0(b ^ 1); ST_LOAD1(tn); BG_ISSUE(tn);
            __builtin_amdgcn_s_setprio(1);
            pv_quad<0>(o, vb, pa0, pa1, pa2, pa3);
            pv_quad<4>(o, vb, pa0, pa1, pa2, pa3);
            __builtin_amdgcn_s_setprio(0);
            ST_WRITE1(b ^ 1);
            LGKM_WAIT0(); __builtin_amdgcn_s_barrier(); SBAR();
        }
        if (grp == 0) __builtin_amdgcn_s_barrier();
        if constexpr (BG) { VM_WAIT0(); }
#undef BG_ISSUE
#undef BG_RSRC
#undef BG_CONSUME
#undef ST_LOAD0
#undef ST_LOAD1
#undef ST_WRITE0
#undef ST_WRITE1
        if (hi == 0) li_l[r32] = l_reg; LGKM_WAIT0();
        const int voS = F.bid * (128 * 512 * 4) + tid * 4;
        if (comp == 0) {
#pragma unroll
            for (int r = 0; r < 16; ++r) { const float rl = __builtin_amdgcn_rcpf(li_l[crow(r, hi)]);
#pragma unroll
                for (int d = 0; d < 8; ++d) __builtin_amdgcn_raw_buffer_store_b32(__float_as_uint(o[d][r] * rl), rW, voS, (int)(unsigned)WS_OSCR + (d * 16 + r) * 2048, 0);
                SBAR(); }
        } else {
            const int vo = ((qb * 256 + wid * 32 + 4 * hi) * D + h * 256 + r32) * 2;
            const __amdgpu_buffer_rsrc_t rG = __builtin_amdgcn_make_buffer_rsrc((void*)subg, 0, VD * 4, 0x00020000);
            float gsub[8];
#pragma unroll
            for (int d = 0; d < 8; ++d) gsub[d] = __uint_as_float(__builtin_amdgcn_raw_buffer_load_b32(rG, r32 * 4, d * 128, 0));
            float ld[4][8], nx[4][8];
#define O0_LOAD(DST, G) do { _Pragma("unroll") for (int rr = 0; rr < 4; ++rr) _Pragma("unroll") for (int d = 0; d < 8; ++d) \
                DST[rr][d] = __uint_as_float(__builtin_amdgcn_raw_buffer_load_b32(rW, voS, (int)(unsigned)WS_OSCR + (d * 16 + 4 * (G) + rr) * 2048, 0)); } while (0)
            O0_LOAD(ld, 0);
#pragma unroll
            for (int g4 = 0; g4 < 4; ++g4) {
                if (g4 + 1 < 4) O0_LOAD(nx, g4 + 1);
                SBAR();
#pragma unroll
                for (int rr = 0; rr < 4; ++rr) { const int r = 4 * g4 + rr; const float rl = __builtin_amdgcn_rcpf(li_l[crow(r, hi)]) * lam; float acc = 0.f; float v[8];
#pragma unroll
                    for (int d = 0; d < 8; ++d) { v[d] = ld[rr][d] - o[d][r] * rl; acc += v[d] * v[d]; }
                    acc += __int_as_float(__builtin_amdgcn_ds_swizzle(__float_as_int(acc), 0x041F)); acc += __int_as_float(__builtin_amdgcn_ds_swizzle(__float_as_int(acc), 0x081F));
                    acc += __int_as_float(__builtin_amdgcn_ds_swizzle(__float_as_int(acc), 0x101F)); acc += __int_as_float(__builtin_amdgcn_ds_swizzle(__float_as_int(acc), 0x201F));
                    acc += __int_as_float(__builtin_amdgcn_ds_swizzle(__float_as_int(acc), 0x401F));
                    const float sc = __builtin_amdgcn_rsqf(acc * (1.0f / 256.0f) + RMS_EPS) * outscale;
#pragma unroll
                    for (int d = 0; d < 8; ++d) { const unsigned w = cvtpk(v[d] * sc * gsub[d], 0.f);
                        __builtin_amdgcn_raw_buffer_store_b16((short)(w & 0xffff), rW, vo, (int)(unsigned)WS_AO + (((r & 3) + 8 * (r >> 2)) * D + d * 32) * 2, 0); } }
                SBAR();
#pragma unroll
                for (int rr = 0; rr < 4; ++rr)
#pragma unroll
                    for (int d = 0; d < 8; ++d) ld[rr][d] = nx[rr][d];
            }
#undef O0_LOAD
        }
        __syncthreads();
    }
}
}

__device__ __forceinline__ void phase_attention(const Ctx& F, int j) {
    unsigned char* const ws = opaque_ws(F.ws);
    const int lane0 = phase_tid() & 63;
    const __amdgpu_buffer_rsrc_t rL = __builtin_amdgcn_make_buffer_rsrc((void*)(as_global(kargs()->in[IN_LAMBDA]) + (size_t)j * 4 * HD), 0, 4 * HD * 4, 0x00020000);
#define LF(i) __uint_as_float(__builtin_amdgcn_raw_buffer_load_b32(rL, lane0 * 4, (i) * 4, 0))
    float a = LF(0) * LF(HD) + LF(64) * LF(HD + 64);
    float b = LF(2 * HD) * LF(3 * HD) + LF(2 * HD + 64) * LF(3 * HD + 64);
#undef LF
    a = wave_sum(a); b = wave_sum(b);
    const float lam_init = (j == 0) ? 0.2f : 0.47071302f;
    const float lam = expf(a) - expf(b) + lam_init;
    const bf16_t* Q = (const bf16_t*)(ws + WS_Q); const bf16_t* K = (const bf16_t*)(ws + WS_K); const bf16_t* V = (const bf16_t*)(ws + WS_V);
    bf16_t* AO = (bf16_t*)(ws + WS_AO);
    const float* subg = as_global(kargs()->in[IN_SUBLN]) + (size_t)j * VD;
    if (j == 0 && F.G == 256) {
        int ui = 0;
        for (int u = F.bid; u < NH * (S / 256); u += F.G, ++ui) { const int h = u & 7, qb = u >> 3; att::attn_unit<true>(F, Q, K, V, AO, subg, lam, 1.0f - lam_init, h, qb, ui * 2); }
    } else {
        for (int u = F.bid; u < NH * (S / 256); u += F.G) { const int h = u & 7, qb = u >> 3; att::attn_unit<false>(F, Q, K, V, AO, subg, lam, 1.0f - lam_init, h, qb, 0); }
    }
}

__device__ __forceinline__ void phase_route(const Ctx& F, int layer, bool commit, int mode) {
    unsigned char* const ws = opaque_ws(F.ws);
    const bf16_t* MIX = (const bf16_t*)(ws + WS_Z); bf16_t* H1B = (bf16_t*)(ws + WS_H1B);
    KArgs KA = kargs(); const float* router_b = as_global(KA->in[IN_ROUTERB]);
    const bf16_t* Hs = (const bf16_t*)(ws + WS_HB);
    const float* g = as_global(KA->in[IN_LNG]) + (size_t)(layer * 2 + 0) * D; const float* bta = as_global(KA->in[IN_LNB]) + (size_t)(layer * 2 + 0) * D;
    int* cnt = (int*)(ws + WS_CTL + CTL_CNT) + layer * 64; int* seg = (int*)(ws + WS_SEG); float* gates = (float*)(ws + WS_GATE);
    const int tid = phase_tid(); const int lane = tid & 63, wid = __builtin_amdgcn_readfirstlane(tid >> 6);
    LAS float* lgp = (LAS float*)(F.lds);
    for (int tile = F.bid; tile < S / 64; tile += F.G) {
        const int tb = tile * 64;
        if (mode != 2) {
            f32x4 v[8]; u32x4 hq3[3][4], mq3[3][4];
#define RT_LOAD(V, MX, R) do { const bf16_t* hr_ = Hs + (size_t)(R) * D + lane * 8; const bf16_t* mr_ = MIX + (size_t)(R) * D + lane * 8; \
            _Pragma("unroll") for (int i = 0; i < 4; ++i) { V[i] = *(const u32x4*)(hr_ + 512 * i); MX[i] = *(const u32x4*)(mr_ + 512 * i); } } while (0)
            RT_LOAD(hq3[0], mq3[0], tb + wid * 8); RT_LOAD(hq3[1], mq3[1], tb + wid * 8 + 1);
            f32x4 gg[8], bb[8];
#pragma unroll
            for (int i = 0; i < 4; ++i) { gg[2 * i] = *(const f32x4*)(g + lane * 8 + 512 * i); gg[2 * i + 1] = *(const f32x4*)(g + lane * 8 + 512 * i + 4);
                bb[2 * i] = *(const f32x4*)(bta + lane * 8 + 512 * i); bb[2 * i + 1] = *(const f32x4*)(bta + lane * 8 + 512 * i + 4); }
#pragma unroll
            for (int r = 0; r < 8; ++r) {
                const int row = tb + wid * 8 + r;
                if (r + 2 < 8) RT_LOAD(hq3[(r + 2) % 3], mq3[(r + 2) % 3], row + 2);
#pragma unroll
                for (int i = 0; i < 4; ++i) { const u32x4 p = mq3[r % 3][i]; f32x4 m0, m1;
                    m0[0] = __uint_as_float(p.x << 16); m0[1] = __uint_as_float(p.x & 0xffff0000u); m0[2] = __uint_as_float(p.y << 16); m0[3] = __uint_as_float(p.y & 0xffff0000u);
                    m1[0] = __uint_as_float(p.z << 16); m1[1] = __uint_as_float(p.z & 0xffff0000u); m1[2] = __uint_as_float(p.w << 16); m1[3] = __uint_as_float(p.w & 0xffff0000u);
                    const u32x4 hq = hq3[r % 3][i]; f32x4 x0, x1;
                    x0[0] = __uint_as_float(hq.x << 16); x0[1] = __uint_as_float(hq.x & 0xffff0000u); x0[2] = __uint_as_float(hq.y << 16); x0[3] = __uint_as_float(hq.y & 0xffff0000u);
                    x1[0] = __uint_as_float(hq.z << 16); x1[1] = __uint_as_float(hq.z & 0xffff0000u); x1[2] = __uint_as_float(hq.w << 16); x1[3] = __uint_as_float(hq.w & 0xffff0000u);
                    v[2 * i] = x0 * ALPHA + m0; v[2 * i + 1] = x1 * ALPHA + m1; }
                float s = 0.f;
#pragma unroll
                for (int i = 0; i < 8; ++i) s += (v[i][0] + v[i][1]) + (v[i][2] + v[i][3]);
                const float mu = wave_sum(s) * (1.0f / D);
                float q = 0.f;
#pragma unroll
                for (int i = 0; i < 8; ++i) { const f32x4 d = v[i] - mu; q += (d[0] * d[0] + d[1] * d[1]) + (d[2] * d[2] + d[3] * d[3]); }
                const float rstd = __builtin_amdgcn_rsqf(wave_sum(q) * (1.0f / D) + LN_EPS);
                bf16_t* hb = H1B + (size_t)row * D + lane * 8;
#pragma unroll
                for (int i = 0; i < 4; ++i) {
                    const f32x4 g0 = gg[2 * i], g1 = gg[2 * i + 1], b0 = bb[2 * i], b1 = bb[2 * i + 1];
                    const f32x4 y0 = (v[2 * i] - mu) * rstd * g0 + b0, y1 = (v[2 * i + 1] - mu) * rstd * g1 + b1;
                    u32x4 w; w.x = cvtpk(y0[0], y0[1]); w.y = cvtpk(y0[2], y0[3]); w.z = cvtpk(y1[0], y1[1]); w.w = cvtpk(y1[2], y1[3]);
                    *(u32x4*)(hb + 512 * i) = w; }
                SBAR();
            }
#undef RT_LOAD
        }
        VM_WAIT0(); __syncthreads();
        if (mode == 1) continue;
        {
            constexpr int ROWB = 272, HALFB = 64 * ROWB, BUFB = 2 * HALFB;
            LAS unsigned char* Bs = F.lds + 32768;
            const int tg = wid & 3, eh = wid >> 2;
            f32x4 acc[2] = {(f32x4){0.f, 0.f, 0.f, 0.f}, (f32x4){0.f, 0.f, 0.f, 0.f}};
            const bf16_t* aph = H1B + (size_t)(tb + tg * 16 + (lane & 15)) * D + 8 * (lane >> 4);
            const int st_hl = tid >> 8, st_e = (tid >> 2) & 63, st_p = tid & 3;
            const bf16_t* sp = (const bf16_t*)(ws + WS_RT) + (size_t)(st_hl * NE + st_e) * D + st_p * 32;
            const int st_off = st_hl * HALFB + st_e * ROWB + st_p * 64;
            const int rd_off = (32 * eh + (lane & 15)) * ROWB + (lane >> 4) * 16;
            u32x4 bst[4]; u32x4 a0[4], n0[4];
#pragma unroll
            for (int j = 0; j < 4; ++j) bst[j] = *(const u32x4*)(sp + 8 * j);
#pragma unroll
            for (int i = 0; i < 4; ++i) { a0[i] = *(const u32x4*)(aph + 32 * i); }
#pragma unroll
            for (int j = 0; j < 4; ++j) *(LAS u32x4*)(Bs + st_off + 16 * j) = bst[j];
            __syncthreads();
#pragma unroll 1
            for (int c = 0; c < 16; ++c) {
                const int cn = c + 1 < 16 ? c + 1 : c;
#pragma unroll
                for (int j = 0; j < 4; ++j) bst[j] = *(const u32x4*)(sp + cn * 128 + 8 * j);
#pragma unroll
                for (int i = 0; i < 4; ++i) { n0[i] = *(const u32x4*)(aph + cn * 128 + 32 * i); }
                LAS unsigned char* Bc = Bs + (c & 1) * BUFB + rd_off;
#pragma unroll
                for (int i = 0; i < 4; ++i) {
                    const bf16x8 ah = *reinterpret_cast<const bf16x8*>(&a0[i]);
#pragma unroll
                    for (int nb = 0; nb < 2; ++nb) {
                        const bf16x8 bh = *(const LAS bf16x8*)(Bc + nb * 16 * ROWB + i * 64), bl = *(const LAS bf16x8*)(Bc + HALFB + nb * 16 * ROWB + i * 64);
                        acc[nb] = __builtin_amdgcn_mfma_f32_16x16x32_bf16(ah, bh, acc[nb], 0, 0, 0);
                        acc[nb] = __builtin_amdgcn_mfma_f32_16x16x32_bf16(ah, bl, acc[nb], 0, 0, 0); }
                }
#pragma unroll
                for (int j = 0; j < 4; ++j) *(LAS u32x4*)(Bs + ((c + 1) & 1) * BUFB + st_off + 16 * j) = bst[j];
#pragma unroll
                for (int i = 0; i < 4; ++i) { a0[i] = n0[i]; }
                __syncthreads();
            }
            LAS float* lg = lgp + tg * (16 * 64);
#pragma unroll
            for (int nb = 0; nb < 2; ++nb)
#pragma unroll
                for (int rg = 0; rg < 4; ++rg) lg[(4 * (lane >> 4) + rg) * 64 + 32 * eh + 16 * nb + (lane & 15)] = acc[nb][rg];
        }
        LGKM_WAIT0(); __syncthreads();
        if (commit && wid < 4 && lane < 16) {
            const int tok = tb + wid * 16 + lane; const LAS float* r0 = lgp + wid * (16 * 64) + lane * 64;
            float bestg = -1e30f; int bg = 0;
#pragma unroll 1
            for (int gi = 0; gi < 8; ++gi) { float m1 = -1e30f, m2 = -1e30f;
#pragma unroll
                for (int e = 0; e < 8; ++e) { const float sc = 1.0f / (1.0f + expf(-r0[gi * 8 + e])) + router_b[gi * 8 + e];
                    if (sc > m1) { m2 = m1; m1 = sc; } else if (sc > m2) m2 = sc; }
                const float gs = m1 + m2; if (gs > bestg) { bestg = gs; bg = gi; } }
            float m1 = -1e30f, m2 = -1e30f; int i1 = 0, i2 = 0;
#pragma unroll
            for (int e = 0; e < 8; ++e) { const float sc = 1.0f / (1.0f + expf(-r0[bg * 8 + e])) + router_b[bg * 8 + e];
                if (sc > m1) { m2 = m1; i2 = i1; m1 = sc; i1 = e; } else if (sc > m2) { m2 = sc; i2 = e; } }
            const int e1 = bg * 8 + i1, e2 = bg * 8 + i2;
            const float s1 = 1.0f / (1.0f + expf(-r0[e1])), s2 = 1.0f / (1.0f + expf(-r0[e2]));
            const float inv = 1.0f / (s1 + s2);
            const int p1 = atomicAdd(cnt + e1, 1), p2 = atomicAdd(cnt + e2, 1);
            seg[(size_t)e1 * SEGCAP + p1] = tok * 2; seg[(size_t)e2 * SEGCAP + p2] = tok * 2 + 1;
            gates[tok * 2] = s1 * inv; gates[tok * 2 + 1] = s2 * inv;
        }
        __syncthreads();
    }
}

__device__ __forceinline__ void phase_combine(const Ctx& F, int layer, float* outp, bool write_hb) {
    unsigned char* const ws = opaque_ws(F.ws);
    const bf16_t* H1B = (const bf16_t*)(ws + WS_H1B); const bf16_t* Y = (const bf16_t*)(ws + WS_Y); bf16_t* HB = (bf16_t*)(ws + WS_HB);
    KArgs KA = kargs();
    const float* g = as_global(KA->in[IN_LNG]) + (size_t)(layer * 2 + 1) * D; const float* bta = as_global(KA->in[IN_LNB]) + (size_t)(layer * 2 + 1) * D;
    const int tid = phase_tid(); const int lane = tid & 63, wid = __builtin_amdgcn_readfirstlane(tid >> 6);
    f32x4 gg[8], bb[8];
#pragma unroll
    for (int i = 0; i < 4; ++i) { gg[2 * i] = *(const f32x4*)(g + lane * 8 + 512 * i); gg[2 * i + 1] = *(const f32x4*)(g + lane * 8 + 512 * i + 4);
        bb[2 * i] = *(const f32x4*)(bta + lane * 8 + 512 * i); bb[2 * i + 1] = *(const f32x4*)(bta + lane * 8 + 512 * i + 4); }
    u32x4 ha[4], na[4]; u32x4 yp[4], yq[4], np[4], nq[4];
    int row = F.bid * 8 + wid;
#define CMB_LOAD(A, P, Q, R) do { const bf16_t* hh_ = H1B + (size_t)(R) * D + lane * 8; const bf16_t* y0_ = Y + (size_t)(2 * (R)) * D + lane * 8; \
        _Pragma("unroll") for (int i = 0; i < 4; ++i) { A[i] = *(const u32x4*)(hh_ + 512 * i); \
            P[i] = *(const u32x4*)(y0_ + 512 * i); Q[i] = *(const u32x4*)(y0_ + D + 512 * i); } } while (0)
    if (row < S) CMB_LOAD(ha, yp, yq, row);
    for (; row < S; row += F.G * 8) {
        const int nrow = row + F.G * 8;
        if (nrow < S) CMB_LOAD(na, np, nq, nrow);
        f32x4 v[8];
#pragma unroll
        for (int i = 0; i < 4; ++i) {
            const u32x4 p = yp[i], q = yq[i];
            f32x4 s0, s1;
            s0[0] = __uint_as_float(p.x << 16) + __uint_as_float(q.x << 16); s0[1] = __uint_as_float(p.x & 0xffff0000u) + __uint_as_float(q.x & 0xffff0000u);
            s0[2] = __uint_as_float(p.y << 16) + __uint_as_float(q.y << 16); s0[3] = __uint_as_float(p.y & 0xffff0000u) + __uint_as_float(q.y & 0xffff0000u);
            s1[0] = __uint_as_float(p.z << 16) + __uint_as_float(q.z << 16); s1[1] = __uint_as_float(p.z & 0xffff0000u) + __uint_as_float(q.z & 0xffff0000u);
            s1[2] = __uint_as_float(p.w << 16) + __uint_as_float(q.w << 16); s1[3] = __uint_as_float(p.w & 0xffff0000u) + __uint_as_float(q.w & 0xffff0000u);
            const u32x4 hh = ha[i]; f32x4 h0, h1v;
            h0[0] = __uint_as_float(hh.x << 16); h0[1] = __uint_as_float(hh.x & 0xffff0000u); h0[2] = __uint_as_float(hh.y << 16); h0[3] = __uint_as_float(hh.y & 0xffff0000u);
            h1v[0] = __uint_as_float(hh.z << 16); h1v[1] = __uint_as_float(hh.z & 0xffff0000u); h1v[2] = __uint_as_float(hh.w << 16); h1v[3] = __uint_as_float(hh.w & 0xffff0000u);
            v[2 * i] = h0 * ALPHA + s0; v[2 * i + 1] = h1v * ALPHA + s1; }
        float s = 0.f;
#pragma unroll
        for (int i = 0; i < 8; ++i) s += (v[i][0] + v[i][1]) + (v[i][2] + v[i][3]);
        const float mu = wave_sum(s) * (1.0f / D);
        float q = 0.f;
#pragma unroll
        for (int i = 0; i < 8; ++i) { const f32x4 d = v[i] - mu; q += (d[0] * d[0] + d[1] * d[1]) + (d[2] * d[2] + d[3] * d[3]); }
        const float rstd = __builtin_amdgcn_rsqf(wave_sum(q) * (1.0f / D) + LN_EPS);
        float* orow = outp + (size_t)row * D + lane * 8; bf16_t* hb = HB + (size_t)row * D + lane * 8;
#pragma unroll
        for (int i = 0; i < 4; ++i) {
            const f32x4 y0v = (v[2 * i] - mu) * rstd * gg[2 * i] + bb[2 * i], y1v = (v[2 * i + 1] - mu) * rstd * gg[2 * i + 1] + bb[2 * i + 1];
            if (!write_hb) { *(f32x4*)(orow + 512 * i) = y0v; *(f32x4*)(orow + 512 * i + 4) = y1v; }
            else { u32x4 w; w.x = cvtpk(y0v[0], y0v[1]); w.y = cvtpk(y0v[2], y0v[3]); w.z = cvtpk(y1v[0], y1v[1]); w.w = cvtpk(y1v[2], y1v[3]);
                *(u32x4*)(hb + 512 * i) = w; } }
#pragma unroll
        for (int i = 0; i < 4; ++i) { ha[i] = na[i]; yp[i] = np[i]; yq[i] = nq[i]; }
    }
#undef CMB_LOAD
}

__device__ __forceinline__ void phase_poolprep(const Ctx& F, const bf16_t* H) {
    unsigned char* const ws = opaque_ws(F.ws);
    bf16_t* Dm = (bf16_t*)(ws + WS_AO);
    const int tid = phase_tid(); const int c8 = (tid & 255) * 8, rh = tid >> 8;
    const int half = 1 << (c8 >> 9);
#define PP_LD(A0, A1, R) do { const u32x4 p_ = *(const u32x4*)(H + (size_t)(R) * D + c8); \
        A0[0] = __uint_as_float(p_.x << 16); A0[1] = __uint_as_float(p_.x & 0xffff0000u); A0[2] = __uint_as_float(p_.y << 16); A0[3] = __uint_as_float(p_.y & 0xffff0000u); \
        A1[0] = __uint_as_float(p_.z << 16); A1[1] = __uint_as_float(p_.z & 0xffff0000u); A1[2] = __uint_as_float(p_.w << 16); A1[3] = __uint_as_float(p_.w & 0xffff0000u); } while (0)
    for (int chunk = F.bid; chunk < S / 64; chunk += F.G) {
        const int t0 = chunk * 64 + rh * 32;
        f32x4 s0 = {0.f, 0.f, 0.f, 0.f}, s1 = {0.f, 0.f, 0.f, 0.f};
        for (int r4 = t0 - half; r4 < t0 + half; r4 += 4) {
            u32x4 pw[4];
#pragma unroll
            for (int q = 0; q < 4; ++q) { const int r = r4 + q; pw[q] = *(const u32x4*)(H + (size_t)(r < 0 ? 0 : r >= S ? S - 1 : r) * D + c8); }
#pragma unroll
            for (int q = 0; q < 4; ++q) { const int r = r4 + q; const float wq = (r >= 0 && r < S && r < t0 + half) ? 1.f : 0.f; f32x4 a0, a1;
                a0[0] = __uint_as_float(pw[q].x << 16); a0[1] = __uint_as_float(pw[q].x & 0xffff0000u); a0[2] = __uint_as_float(pw[q].y << 16); a0[3] = __uint_as_float(pw[q].y & 0xffff0000u);
                a1[0] = __uint_as_float(pw[q].z << 16); a1[1] = __uint_as_float(pw[q].z & 0xffff0000u); a1[2] = __uint_as_float(pw[q].w << 16); a1[3] = __uint_as_float(pw[q].w & 0xffff0000u);
                s0 += a0 * wq; s1 += a1 * wq; }
        }
#define PP_UP(A0, A1, P) do { const u32x4 p_ = (P); \
        A0[0] = __uint_as_float(p_.x << 16); A0[1] = __uint_as_float(p_.x & 0xffff0000u); A0[2] = __uint_as_float(p_.y << 16); A0[3] = __uint_as_float(p_.y & 0xffff0000u); \
        A1[0] = __uint_as_float(p_.z << 16); A1[1] = __uint_as_float(p_.z & 0xffff0000u); A1[2] = __uint_as_float(p_.w << 16); A1[3] = __uint_as_float(p_.w & 0xffff0000u); } while (0)
#pragma unroll 1
        for (int t4 = t0; t4 < t0 + 32; t4 += 4) {
            u32x4 px[4], pa[4], pd[4];
#pragma unroll
            for (int q = 0; q < 4; ++q) { const int t = t4 + q, ra = t + half, rd = t - half;
                px[q] = *(const u32x4*)(H + (size_t)t * D + c8); pa[q] = *(const u32x4*)(H + (size_t)(ra < S ? ra : S - 1) * D + c8); pd[q] = *(const u32x4*)(H + (size_t)(rd >= 0 ? rd : 0) * D + c8); }
#pragma unroll
            for (int q = 0; q < 4; ++q) { const int t = t4 + q, ra = t + half, rd = t - half;
                const int lo = rd < 0 ? 0 : rd, hiw = ra > S ? S : ra;
                const float inv = 1.0f / (float)(hiw - lo);
                f32x4 x0, x1; PP_UP(x0, x1, px[q]);
                const f32x4 d0 = s0 * inv - x0, d1 = s1 * inv - x1;
                u32x4 w; w.x = cvtpk(d0[0], d0[1]); w.y = cvtpk(d0[2], d0[3]); w.z = cvtpk(d1[0], d1[1]); w.w = cvtpk(d1[2], d1[3]);
                *(u32x4*)(Dm + (size_t)t * D + c8) = w;
                const float wa = ra < S ? 1.f : 0.f, wd = rd >= 0 ? 1.f : 0.f; f32x4 a0, a1, e0, e1;
                PP_UP(a0, a1, pa[q]); PP_UP(e0, e1, pd[q]);
                s0 += a0 * wa - e0 * wd; s1 += a1 * wa - e1 * wd; }
        }
#undef PP_UP
    }
#undef PP_LD
}

__device__ __forceinline__ void moe_tables(const Ctx& F, int layer) {
    unsigned char* const ws = opaque_ws(F.ws);
    LAS int* tab = (LAS int*)(F.lds + LDS_MISC + 64);
    const int* cnt = (const int*)(ws + WS_CTL + CTL_CNT) + layer * 64;
    const int tid = phase_tid();
    if (tid < 64) tab[tid] = cnt[tid];
    __syncthreads();
    if (tid == 0) { int to = 0, ro = 0; for (int e = 0; e < 64; ++e) { tab[64 + e] = to; tab[129 + e] = ro; const int c = tab[e]; to += (c + 255) >> 8; ro += c; } tab[128] = to; tab[193] = ro; }
    __syncthreads();
}

constexpr int N_PHASES = 1 + 8 * DEPTH;
__global__ void __launch_bounds__(NTHREADS, 2) fwd(Args args) {
    extern __shared__ __attribute__((aligned(16))) unsigned char lds_raw[];
    Ctx F;
    F.ws = as_global(args.ws); F.lds = (LAS unsigned char*)lds_raw; F.wv = __builtin_amdgcn_readfirstlane(threadIdx.x >> 6);
    F.G = gridDim.x; F.bid = blockIdx.x;
    const int lo = args.ph_lo, hi = args.ph_hi;
    XcdBarrier bar; bar.bar = (unsigned*)(F.ws + WS_CTL); bar.x = 0; bar.st = (volatile LAS unsigned*)(F.lds + LDS_MISC);
    if (threadIdx.x < 4) ((LAS unsigned*)(F.lds + LDS_MISC))[threadIdx.x] = 0u;
    __syncthreads();
    const bool multi = (hi - lo) > 1;
    if (multi) bar = xcd_barrier_post((unsigned*)(F.ws + WS_CTL), (volatile LAS unsigned*)(F.lds + LDS_MISC));
#define IN(k) (lo <= (k) && (k) < hi)
#define SEAM(k) do { if (IN(k) && IN((k) + 1)) { xcd_barrier(bar); if (PROBE_BAR) xcd_barrier(bar); } } while (0)

    if constexpr (PHMASK & 1) if (IN(0)) { REPEAT(REP_PRO) phase_prologue(F); }
    SEAM(0);
#pragma unroll 1
    for (int layer = 0; layer < DEPTH; ++layer) {
        const int pb = 1 + 8 * layer; const int j = layer >> 1;
        if ((layer & 1) == 0) {
            if constexpr (PHMASK & 2) if (IN(pb + 0)) {     unsigned char* const ws = opaque_ws(F.ws);
                pg8::DenseOrder Sd; Sd.init(ws + WS_HB, ws + WS_WQKV + (size_t)j * 6144 * 2048 * 2, D, D, S, 3 * D, F.G, F.bid);
                pg8::EpiQKV E{(bf16_t*)(ws + WS_Q), (const float*)(ws + WS_ROPE)};
                REPEAT(REP_GEMM) pg8::gemm_phase<pg8::EpiQKV, pg8::DenseOrder, false>(F.lds, F.wv, D, D, D, Sd, E);
            }
            SEAM(pb + 0);
            if constexpr (PHMASK & 4) if (IN(pb + 1)) { REPEAT(REP_ATT) phase_attention(F, j); }
            SEAM(pb + 1);
            if constexpr (PHMASK & 8) if (IN(pb + 2)) {     unsigned char* const ws = opaque_ws(F.ws);
                pg8::DenseOrder Sd; Sd.init(ws + WS_AO, ws + WS_WO + (size_t)j * 2048 * 2048 * 2, D, D, S, D, F.G, F.bid);
                pg8::EpiMix E{(bf16_t*)(ws + WS_Z), nullptr};
                REPEAT(REP_GEMM) pg8::gemm_phase<pg8::EpiMix, pg8::DenseOrder, false>(F.lds, F.wv, D, D, D, Sd, E);
            }
            SEAM(pb + 2);
        } else {
            if constexpr (PHMASK & 16) if (IN(pb + 0)) { REPEAT(REP_TOK) phase_poolprep(F, (const bf16_t*)(opaque_ws(F.ws) + WS_HB)); }
            SEAM(pb + 0);
            if constexpr (PHMASK & 32) if (IN(pb + 1)) {     unsigned char* const ws = opaque_ws(F.ws);
                pg8::PoolOrder Sp{(const char*)(ws + WS_AO), (const char*)(ws + WS_WPOOL + (size_t)j * 4 * 512 * 512 * 2), F.G, F.bid};
                pg8::EpiMix E{(bf16_t*)(ws + WS_Z), as_global(kargs()->in[IN_POOLSC]) + (size_t)j * D};
                REPEAT(REP_GEMM) pg8::gemm_phase<pg8::EpiMix, pg8::PoolOrder, false>(F.lds, F.wv, 512, D, 512, Sp, E);
            }
            SEAM(pb + 1);
        }
        if constexpr (PHMASK & 64) if (IN(pb + 3)) { REPEAT(REP_ROUTE) phase_route(F, layer, rep_ == REP_ROUTE - 1, rep_ == REP_ROUTE - 1 ? 0 : PROBE_RMODE); }
        SEAM(pb + 3);
        if constexpr (PHMASK & 128) if (IN(pb + 4)) {         unsigned char* const ws = opaque_ws(F.ws);
            moe_tables(F, layer);
            pg8::MoeOrder Sm{(const LAS int*)(F.lds + LDS_MISC + 64), (const char*)(ws + WS_H1B), (const char*)(ws + WS_WIN + (size_t)layer * 64 * 1024 * 2048 * 2), (const int*)(ws + WS_SEG), 4, F.G, F.bid, 0, (size_t)1024 * 2048 * 2};
            pg8::EpiMoeIn E{(bf16_t*)(ws + WS_HACT)};
            REPEAT(REP_MOE) pg8::gemm_phase<pg8::EpiMoeIn, pg8::MoeOrder, true>(F.lds, F.wv, D, D, D, Sm, E);
        }
        SEAM(pb + 4);
        if constexpr (PHMASK & 256) if (IN(pb + 5)) {         unsigned char* const ws = opaque_ws(F.ws);
            moe_tables(F, layer);
            pg8::MoeOrder Sm{(const LAS int*)(F.lds + LDS_MISC + 64), (const char*)(ws + WS_HACT), (const char*)(ws + WS_WOUT + (size_t)layer * 64 * 2048 * 512 * 2), (const int*)(ws + WS_SEG), 8, F.G, F.bid, 1, (size_t)2048 * 512 * 2};
            pg8::EpiMoeOut E{(bf16_t*)(ws + WS_Y), (const float*)(ws + WS_GATE)};
            REPEAT(REP_MOE) pg8::gemm_phase<pg8::EpiMoeOut, pg8::MoeOrder, false>(F.lds, F.wv, DFF, DFF, DFF, Sm, E);
        }
        SEAM(pb + 5);
        if constexpr (PHMASK & 512) if (IN(pb + 6)) { REPEAT(REP_TOK) phase_combine(F, layer, as_global(kargs()->out), layer != DEPTH - 1); }
        if (layer + 1 < DEPTH) SEAM(pb + 6);
    }
#undef IN
#undef SEAM
}

extern "C" void kernel_launch(void* const* d_in, const int* in_sizes, int n_in, void* d_out, int out_size, void* d_ws, size_t ws_size, hipStream_t stream) {
    static int grid = 0;
    if (grid == 0) {
        if (n_in != 13 || out_size != S * D || ws_size < WS_END) { fprintf(stderr, "kernel_launch: unexpected shapes (n_in %d out %d ws %zu, need %zu)\n", n_in, out_size, ws_size, (size_t)WS_END); grid = -1; return; }
        int dev = 0, cus = 0, per_cu = 0;
        if (hipGetDevice(&dev) != hipSuccess || hipDeviceGetAttribute(&cus, hipDeviceAttributeMultiprocessorCount, dev) != hipSuccess) { grid = -1; return; }
        if (hipFuncSetAttribute((const void*)fwd, hipFuncAttributeMaxDynamicSharedMemorySize, LDS_BYTES) != hipSuccess) { fprintf(stderr, "kernel_launch: hipFuncSetAttribute failed\n"); grid = -1; return; }
        if (hipOccupancyMaxActiveBlocksPerMultiprocessor(&per_cu, (const void*)fwd, NTHREADS, LDS_BYTES) != hipSuccess || per_cu < 1) { fprintf(stderr, "kernel_launch: occupancy query says %d\n", per_cu); }
        (void)hipGetLastError();
        grid = cus;
    }
    if (grid < 0) return;
    (void)hipMemsetAsync((char*)d_ws + WS_CTL, 0, CTL_ZERO_BYTES, stream);
    Args a{};
    for (int i = 0; i < 13; ++i) a.in[i] = (const float*)d_in[i];
    a.out = (float*)d_out; a.ws = (unsigned char*)d_ws;
#if ONE_LAUNCH
    a.ph_lo = 0; a.ph_hi = N_PHASES;
    hipLaunchKernelGGL(fwd, dim3(grid), dim3(NTHREADS), LDS_BYTES, stream, a);
#else
    for (int p = 0; p < N_PHASES; ++p) {
        const int sub = (p - 1) & 7, layer = (p - 1) >> 3;
        if (p > 0 && (sub == 7 || ((layer & 1) == 1 && sub == 2))) continue;
        a.ph_lo = p; a.ph_hi = p + 1;
        hipLaunchKernelGGL(fwd, dim3(grid), dim3(NTHREADS), LDS_BYTES, stream, a);
    }
#endif
}
```

```cpp
#include <hip/hip_runtime.h>
#include <stdint.h>
#include <stdio.h>

#ifndef PHMASK
#define PHMASK 0xFFFF
#endif
#ifndef PROBE_BAR
#define PROBE_BAR 0
#endif
#ifndef REP_ROUTE
#define REP_ROUTE 1
#endif
#ifndef PROBE_RMODE
#define PROBE_RMODE 0
#endif
#ifndef PROBE_GMFMA
#define PROBE_GMFMA 0
#endif
#ifndef REP_ATT
#define REP_ATT 1
#endif
#ifndef REP_GEMM
#define REP_GEMM 1
#endif
#ifndef REP_MOE
#define REP_MOE 1
#endif
#ifndef REP_PRO
#define REP_PRO 1
#endif
#ifndef REP_TOK
#define REP_TOK 1
#endif
#define REPEAT(n) _Pragma("unroll 1") for (int rep_ = 0; rep_ < (n); ++rep_)
#ifndef ONE_LAUNCH
#define ONE_LAUNCH 1
#endif

#define LAS __attribute__((address_space(3)))
typedef unsigned short bf16_t;
typedef short bf16x8 __attribute__((ext_vector_type(8)));
typedef short s16x4 __attribute__((ext_vector_type(4)));
typedef float f32x2 __attribute__((ext_vector_type(2)));
typedef float f32x4 __attribute__((ext_vector_type(4)));
typedef float f32x16 __attribute__((ext_vector_type(16)));
typedef unsigned u32x2 __attribute__((ext_vector_type(2)));
typedef unsigned u32x4 __attribute__((ext_vector_type(4)));

constexpr int S = 16384, D = 2048, DEPTH = 4, NE = 64, DFF = 512, NH = 8, HD = 128, VD = 256;
constexpr float ALPHA = 1.6817928305074292f;
constexpr float LN_EPS = 1e-5f, RMS_EPS = 1e-5f;
constexpr int NTHREADS = 512;
constexpr int SEGCAP = S;

constexpr size_t AL(size_t x) { return (x + 255) / 256 * 256; }
constexpr size_t WS_CTL   = 0;
constexpr size_t CTL_BAR_WORDS = 3456;
constexpr size_t CTL_CNT  = 16384;
constexpr size_t CTL_ZERO_BYTES = 20480;
constexpr size_t WS_WQKV  = AL(WS_CTL + CTL_ZERO_BYTES);
constexpr size_t WS_WO    = AL(WS_WQKV + (size_t)2 * 6144 * 2048 * 2);
constexpr size_t WS_WPOOL = AL(WS_WO + (size_t)2 * 2048 * 2048 * 2);
constexpr size_t WS_WIN   = AL(WS_WPOOL + (size_t)8 * 512 * 512 * 2);
constexpr size_t WS_WOUT  = AL(WS_WIN + (size_t)256 * 1024 * 2048 * 2);
constexpr size_t WS_ROPE  = AL(WS_WOUT + (size_t)256 * 2048 * 512 * 2);
constexpr size_t WS_H     = AL(WS_ROPE + (size_t)S * 32 * 4);
constexpr size_t WS_HB    = AL(WS_H + (size_t)S * D * 4);
constexpr size_t WS_Q     = AL(WS_HB + (size_t)S * D * 2);
constexpr size_t WS_K     = AL(WS_Q + (size_t)S * D * 2);
constexpr size_t WS_V     = AL(WS_K + (size_t)S * D * 2);
constexpr size_t WS_AO    = AL(WS_V + (size_t)S * D * 2);
constexpr size_t WS_Z     = AL(WS_AO + (size_t)S * D * 2);
constexpr size_t WS_H1    = AL(WS_Z + (size_t)S * D * 4);
constexpr size_t WS_H1B   = AL(WS_H1 + (size_t)S * D * 4);
constexpr size_t WS_HACT  = AL(WS_H1B + (size_t)S * D * 2);
constexpr size_t WS_Y     = AL(WS_HACT + (size_t)(2 * S + 256) * DFF * 2);
constexpr size_t WS_SEG   = AL(WS_Y + (size_t)2 * S * D * 2);
constexpr size_t WS_GATE  = AL(WS_SEG + (size_t)NE * SEGCAP * 4);
constexpr size_t WS_OSCR  = AL(WS_GATE + (size_t)2 * S * 4);
constexpr size_t WS_RT    = AL(WS_OSCR + (size_t)256 * 512 * 128 * 4);
constexpr size_t WS_END   = AL(WS_RT + (size_t)2 * NE * D * 2);
static_assert(WS_V - WS_K == WS_K - WS_Q, "q|k|v spacing");
static_assert(WS_END < 0xFFFFFFFFull, "workspace offsets must fit 32 bits (buffer addressing)");

constexpr int LDS_BYTES = 147456;
constexpr int LDS_MISC  = 131072;

__device__ __forceinline__ unsigned cvtpk(float lo, float hi) { unsigned r; asm volatile("v_cvt_pk_bf16_f32 %0, %1, %2" : "=v"(r) : "v"(lo), "v"(hi)); return r; }
#define SWZ_ADD(v, pat) v += __int_as_float(__builtin_amdgcn_ds_swizzle(__float_as_int(v), pat))
__device__ __forceinline__ float wave_sum(float v) {
    SWZ_ADD(v, 0x041F); SWZ_ADD(v, 0x081F); SWZ_ADD(v, 0x101F); SWZ_ADD(v, 0x201F); SWZ_ADD(v, 0x401F);
    auto rr = __builtin_amdgcn_permlane32_swap(__float_as_uint(v), __float_as_uint(v), false, false);
    return __uint_as_float(rr[0]) + __uint_as_float(rr[1]);
}
template <class T> __device__ __forceinline__ T* as_global(T* p) { return (T*)(__attribute__((address_space(1))) T*)p; }
#define VM_WAIT0() asm volatile("s_waitcnt vmcnt(0)" ::: "memory")
#define LGKM_WAIT0() asm volatile("s_waitcnt lgkmcnt(0)" ::: "memory")
#define SBAR() __builtin_amdgcn_sched_barrier(0)
__device__ __forceinline__ int phase_tid_w(int wv) { unsigned all = ~0u; asm volatile("" : "+s"(all)); return wv * 64 + (int)__builtin_amdgcn_mbcnt_hi(all, __builtin_amdgcn_mbcnt_lo(all, 0u)); }
#define phase_tid() phase_tid_w(F.wv)

#define XB_TMO      128
#define XB_XCNT(j)  (256  + 64 * (j))
#define XB_XSUB(j)  (1280 + 64 * (j))
#define XB_XGEN(j)  (2304 + 64 * (j))
#define XB_TOP      3328
#define XB_TOPGEN   3392
#define XCD_BAR_WORDS 3456
#define XB_SPIN_CAP (1u << 18)

__device__ __forceinline__ unsigned xb_ld(unsigned* p)              { return __hip_atomic_load(p, __ATOMIC_RELAXED, __HIP_MEMORY_SCOPE_AGENT); }
__device__ __forceinline__ unsigned xb_add(unsigned* p, unsigned v) { return __hip_atomic_fetch_add(p, v, __ATOMIC_RELAXED, __HIP_MEMORY_SCOPE_AGENT); }
__device__ __forceinline__ unsigned xb_xcc_id() { return (unsigned)__builtin_amdgcn_s_getreg((3 << 11) | 20) & 0xFu; }
#define XB_SPIN(cond, bar) do { unsigned _sp = 0; while (cond) { __builtin_amdgcn_s_sleep(1); \
    if ((++_sp & 255u) == 0u) { if (xb_ld(&(bar)[XB_TMO])) break; if (_sp > XB_SPIN_CAP) { atomicAdd(&(bar)[XB_TMO], 1u); break; } } } } while (0)

struct XcdBarrier { unsigned* bar; unsigned x; volatile LAS unsigned* st; };

__device__ __forceinline__ XcdBarrier xcd_barrier_post(unsigned* bar, volatile LAS unsigned* st) {
    XcdBarrier b; b.bar = bar; b.x = xb_xcc_id(); b.st = st;
    if (threadIdx.x == 0) (void)xb_add(&bar[XB_XCNT(b.x)], 1u);
    return b;
}
__device__ __forceinline__ void xcd_barrier_complete(unsigned* bar, unsigned x, unsigned& nloc, unsigned& nx) {
    const unsigned G = gridDim.x * gridDim.y * gridDim.z;
    unsigned sum, cnt, mine, sp = 0u;
    for (;;) {
        sum = 0u; cnt = 0u;
#pragma unroll 1
        for (unsigned j = 0; j < 16; ++j) { const unsigned c = xb_ld(&bar[XB_XCNT(j)]); sum += c; cnt += (c > 0u) ? 1u : 0u; }
        mine = xb_ld(&bar[XB_XCNT(x)]);
        if (sum == G) break;
        __builtin_amdgcn_s_sleep(1);
        if ((++sp & 255u) == 0u) { if (xb_ld(&bar[XB_TMO])) break; if (sp > XB_SPIN_CAP) { atomicAdd(&bar[XB_TMO], 1u); break; } }
    }
    nloc = mine > 0u ? mine : 1u; nx = cnt > 0u ? cnt : 1u;
}
__device__ __forceinline__ void xcd_barrier(const XcdBarrier& b) {
    asm volatile("s_waitcnt vmcnt(0)" ::: "memory");
    __syncthreads();
    if (threadIdx.x == 0) {
        unsigned* bar; { size_t z = 0; asm volatile("" : "+s"(z)); bar = as_global(b.bar) + z; }
        __builtin_amdgcn_s_waitcnt(0);
        unsigned nloc = b.st[0], nx = b.st[1];
        if (nloc == 0u) { xcd_barrier_complete(bar, b.x, nloc, nx); b.st[0] = nloc; b.st[1] = nx; }
        const unsigned old = xb_add(&bar[XB_XSUB(b.x)], 1u);
        const unsigned gen = old / nloc;
        if (old + 1u == (gen + 1u) * nloc) {
            __builtin_amdgcn_fence(__ATOMIC_RELEASE, "agent");
            asm volatile("s_waitcnt vmcnt(0)" ::: "memory");
            const unsigned og = xb_add(&bar[XB_TOP], 1u);
            const unsigned tg = og / nx;
            if (og + 1u == (tg + 1u) * nx) xb_add(&bar[XB_TOPGEN], 1u);
            else XB_SPIN(xb_ld(&bar[XB_TOPGEN]) == tg, bar);
            __builtin_amdgcn_fence(__ATOMIC_ACQUIRE, "agent");
            xb_add(&bar[XB_XGEN(b.x)], 1u);
            asm volatile("s_waitcnt vmcnt(0)" ::: "memory");
        } else {
            XB_SPIN(xb_ld(&bar[XB_XGEN(b.x)]) == gen, bar);
            __builtin_amdgcn_fence(__ATOMIC_ACQUIRE, "agent");
            asm volatile("s_waitcnt vmcnt(0)" ::: "memory");
        }
    }
    __syncthreads();
}

namespace pg8 {
constexpr int BM = 256, BK = 64, HALF = 128, HTB = HALF * BK * 2, STAGE_BYTES = 8 * HTB;
__device__ __forceinline__ int lds_byte(int r, int c) { const int st = (r >> 4) * 2 + (c >> 5), rr = r & 15, cc = c & 31, ob = rr * 64 + cc * 2; return st * 1024 + (ob ^ (((ob >> 9) & 1) << 5)); }
__device__ __forceinline__ void stage_rc(int b, int& R, int& C) { const int st = b / 1024, sb = b % 1024, swz = sb ^ (((sb >> 9) & 1) << 5); R = (st >> 1) * 16 + swz / 64; C = (st & 1) * 32 + (swz % 64) / 2; }

struct GUnit { const char* A; const char* B; const int* list; int nvalid; int r0; int c0; int aux; int pad; };

template <class Epi, class Sched, bool GATHER>
__device__ __forceinline__ void gemm_phase(LAS unsigned char* lds, const int wv, const int K, const int lda, const int ldb, const Sched& Sch, const Epi& E) {
    const int tid = phase_tid_w(wv), wid = __builtin_amdgcn_readfirstlane(tid >> 6), lane = tid & 63, wr = wid >> 2, wc = wid & 3, fr = lane & 15, fq = lane >> 4;
    const int nt = K / BK;
    int stR[2], stC[2];
    unsigned voffA[2], voffB[2];
#pragma unroll
    for (int i = 0; i < 2; ++i) { stage_rc(tid * 16 + i * 8192, stR[i], stC[i]);
        voffA[i] = (unsigned)(stR[i] * lda + stC[i]) * 2u; voffB[i] = (unsigned)(stR[i] * ldb + stC[i]) * 2u; }
    unsigned vgc[2][2], vgn[2][2];
    const size_t kstep = (size_t)(BK * 2);
    const size_t hstepA = (size_t)HALF * lda * 2, hstepB = (size_t)HALF * ldb * 2;
    const unsigned ldsw = (unsigned)wid * 1024u;
    const int aoff = lds_byte(wr * 64 + fr, fq * 8), boff = lds_byte(wc * 32 + fr, fq * 8);
#define PG8_SA(b, h) (((b) * 2 + (h)) * HTB)
#define PG8_SB(b, h) ((4 + (b) * 2 + (h)) * HTB)
#define PG8_RAW(bufoff, p0, p1) do { \
        __builtin_amdgcn_global_load_lds((const unsigned*)(p0), (LAS unsigned*)(lds + (bufoff) + ldsw), 16, 0, 0); \
        __builtin_amdgcn_global_load_lds((const unsigned*)(p1), (LAS unsigned*)(lds + (bufoff) + ldsw + 8192), 16, 0, 0); } while (0)
#define PG8_STB(bufoff, gbase) PG8_RAW(bufoff, (gbase) + voffB[0], (gbase) + voffB[1])
#define PG8_STA(bufoff, gbase, h, nx) do { if constexpr (GATHER) { const unsigned _o0 = (nx) ? vgn[h][0] : vgc[h][0], _o1 = (nx) ? vgn[h][1] : vgc[h][1]; PG8_RAW(bufoff, (gbase) + _o0, (gbase) + _o1); } \
        else { PG8_RAW(bufoff, (gbase) + (h) * hstepA + voffA[0], (gbase) + (h) * hstepA + voffA[1]); } } while (0)
#define PG8_LDA(dst, b, h) do { _Pragma("unroll") for (int m = 0; m < 4; ++m) _Pragma("unroll") for (int k = 0; k < 2; ++k) dst[m][k] = *(const LAS bf16x8*)(lds + PG8_SA(b, h) + aoff + m * 2048 + k * 1024); } while (0)
#define PG8_LDB(dst, b, h) do { _Pragma("unroll") for (int n = 0; n < 2; ++n) _Pragma("unroll") for (int k = 0; k < 2; ++k) dst[n][k] = *(const LAS bf16x8*)(lds + PG8_SB(b, h) + boff + n * 2048 + k * 1024); } while (0)
#define PG8_MMA(ai, bj, At, Bt) do { __builtin_amdgcn_s_setprio(1); _Pragma("unroll") for (int m = 0; m < 4; ++m) _Pragma("unroll") for (int n = 0; n < 2; ++n) _Pragma("unroll") for (int k = 0; k < 2; ++k) \
        acc[ai][bj][m][n] = __builtin_amdgcn_mfma_f32_16x16x32_bf16(Bt[n][k], At[m][k], acc[ai][bj][m][n], 0, 0, 0); \
        if (PROBE_GMFMA) { bf16x8 zz = {0, 0, 0, 0, 0, 0, 0, 0}; asm volatile("" : "+v"(zz)); _Pragma("unroll") for (int m = 0; m < 4; ++m) acc[ai][bj][m][0] = __builtin_amdgcn_mfma_f32_16x16x32_bf16(zz, At[m][0], acc[ai][bj][m][0], 0, 0, 0); } \
        __builtin_amdgcn_s_setprio(0); } while (0)
#define PG8_WAIT_V(n) asm volatile("s_waitcnt vmcnt(" #n ")" ::: "memory")
#define PG8_WAIT_L(n) asm volatile("s_waitcnt lgkmcnt(" #n ")" ::: "memory")
#define PG8_BAR __builtin_amdgcn_s_barrier()
#define PG8_SCHED __builtin_amdgcn_sched_barrier(0)
#define PG8_GOFF(dst, u) do { _Pragma("unroll") for (int h = 0; h < 2; ++h) _Pragma("unroll") for (int i = 0; i < 2; ++i) { \
        const int rr = h * HALF + stR[i]; const int sl = (u).list[rr < (u).nvalid ? rr : 0]; dst[h][i] = (unsigned)((sl >> 1) * lda + stC[i]) * 2u; } } while (0)
    GUnit cur, nxt; int ui = 0;
    if (!Sch.next(0, cur)) return;
    f32x4 acc[2][2][4][2];
#pragma unroll
    for (int a = 0; a < 2; ++a)
#pragma unroll
        for (int b = 0; b < 2; ++b)
#pragma unroll
            for (int m = 0; m < 4; ++m)
#pragma unroll
                for (int n = 0; n < 2; ++n) acc[a][b][m][n] = (f32x4){0.f, 0.f, 0.f, 0.f};
    bf16x8 At[4][2], B0[2][2], B1[2][2];
    const char* cA = cur.A; const char* cB = cur.B;
    if constexpr (GATHER) { PG8_GOFF(vgc, cur); }
    PG8_STB(PG8_SB(0, 0), cB); PG8_STA(PG8_SA(0, 0), cA, 0, false); PG8_STB(PG8_SB(0, 1), cB + hstepB); PG8_STA(PG8_SA(0, 1), cA, 1, false);
    if (wr == 1) PG8_BAR;
    PG8_WAIT_V(4); PG8_BAR;
    PG8_STB(PG8_SB(1, 0), cB + kstep); PG8_STA(PG8_SA(1, 0), cA + kstep, 0, false); PG8_STB(PG8_SB(1, 1), cB + hstepB + kstep);
    PG8_WAIT_V(6); PG8_BAR;
    for (;;) {
        const bool has_next = Sch.next(ui + 1, nxt);
        const char* nA = has_next ? nxt.A : cA; const char* nB = has_next ? nxt.B : cB;
        if constexpr (GATHER) {
            if (has_next) { PG8_GOFF(vgn, nxt); }
            else {
#pragma unroll
                for (int h = 0; h < 2; ++h)
#pragma unroll
                    for (int i = 0; i < 2; ++i) vgn[h][i] = vgc[h][i]; }
        }
        for (int t = 0; t < nt; t += 2) {
            const bool last = (t == nt - 2);
            const char* a1 = cA + (size_t)(t + 1) * kstep;
            const char* a2 = last ? nA : cA + (size_t)(t + 2) * kstep; const char* b2 = last ? nB : cB + (size_t)(t + 2) * kstep;
            const char* a3 = a2 + kstep; const char* b3 = b2 + kstep;
            PG8_LDB(B0, 0, 0); PG8_SCHED; PG8_LDA(At, 0, 0); PG8_STA(PG8_SA(1, 1), a1, 1, false);
            PG8_WAIT_L(8); PG8_BAR; PG8_WAIT_L(0); PG8_MMA(0, 0, At, B0); PG8_BAR; PG8_SCHED;
            PG8_LDB(B1, 0, 1); PG8_STB(PG8_SB(0, 0), b2);
            PG8_BAR; PG8_WAIT_L(0); PG8_MMA(0, 1, At, B1); PG8_BAR;
            PG8_LDA(At, 0, 1); PG8_STA(PG8_SA(0, 0), a2, 0, last);
            PG8_BAR; PG8_WAIT_L(0); PG8_MMA(1, 0, At, B0); PG8_BAR; PG8_SCHED;
            PG8_STB(PG8_SB(0, 1), b2 + hstepB);
            PG8_WAIT_V(6); PG8_BAR; PG8_MMA(1, 1, At, B1); PG8_BAR;
            PG8_LDB(B0, 1, 0); PG8_SCHED; PG8_LDA(At, 1, 0); PG8_STA(PG8_SA(0, 1), a2, 1, last);
            PG8_WAIT_L(8); PG8_BAR; PG8_WAIT_L(0); PG8_MMA(0, 0, At, B0); PG8_BAR; PG8_SCHED;
            PG8_LDB(B1, 1, 1); PG8_STB(PG8_SB(1, 0), b3);
            PG8_BAR; PG8_WAIT_L(0); PG8_MMA(0, 1, At, B1); PG8_BAR;
            PG8_LDA(At, 1, 1); PG8_STA(PG8_SA(1, 0), a3, 0, last);
            PG8_BAR; PG8_WAIT_L(0); PG8_MMA(1, 0, At, B0); PG8_BAR; PG8_SCHED;
            PG8_STB(PG8_SB(1, 1), b3 + hstepB);
            PG8_WAIT_V(6); PG8_BAR; PG8_MMA(1, 1, At, B1); PG8_BAR;
        }
        E(acc, cur, wr, wc, fr, fq);
        if (!has_next) break;
#pragma unroll
        for (int a = 0; a < 2; ++a)
#pragma unroll
            for (int b = 0; b < 2; ++b)
#pragma unroll
                for (int m = 0; m < 4; ++m)
#pragma unroll
                    for (int n = 0; n < 2; ++n) acc[a][b][m][n] = (f32x4){0.f, 0.f, 0.f, 0.f};
        cur = nxt; cA = nA; cB = nB; ++ui;
        if constexpr (GATHER) {
#pragma unroll
            for (int h = 0; h < 2; ++h)
#pragma unroll
                for (int i = 0; i < 2; ++i) vgc[h][i] = vgn[h][i]; }
    }
    PG8_WAIT_V(0);
    if (wr == 0) PG8_BAR;
    PG8_BAR;
#undef PG8_SA
#undef PG8_SB
#undef PG8_RAW
#undef PG8_STB
#undef PG8_STA
#undef PG8_LDA
#undef PG8_LDB
#undef PG8_MMA
#undef PG8_WAIT_V
#undef PG8_WAIT_L
#undef PG8_BAR
#undef PG8_SCHED
#undef PG8_GOFF
}

struct DenseOrder {
    const char* A; const char* B; int lda, ldb; int nM, nN, nwg, G, c;
    __device__ __forceinline__ void init(const void* A_, const void* B_, int lda_, int ldb_, int M, int N, int G_, int c_) { A = (const char*)A_; B = (const char*)B_; lda = lda_; ldb = ldb_; nM = M / BM; nN = N / BM; nwg = nM * nN; G = G_; c = c_; }
    __device__ __forceinline__ bool next(int i, GUnit& u) const {
        const long L = (long)i * G + c; if (L >= nwg) return false;
        int wgid = (int)L; { const int q = nwg / 8, r = nwg % 8, xcd = wgid % 8, off = wgid / 8; wgid = (xcd < r ? xcd * (q + 1) : r * (q + 1) + (xcd - r) * q) + off; }
        const int nig = 8 * nN, gid = wgid / nig, fm = gid * 8, gsz = (nM - fm) < 8 ? (nM - fm) : 8;
        const int pm = fm + ((wgid % nig) % gsz), pn = (wgid % nig) / gsz;
        u.A = A + (size_t)pm * BM * lda * 2; u.B = B + (size_t)pn * BM * ldb * 2; u.list = nullptr; u.nvalid = 256; u.r0 = pm * BM; u.c0 = pn * BM; u.aux = 0; u.pad = 0; return true;
    }
};
struct PoolOrder {
    const char* A; const char* B; int G, c;
    __device__ __forceinline__ bool next(int i, GUnit& u) const {
        const int L = i * G + c; if (L >= 512) return false;
        const int g = L >> 7, pm = (L & 127) >> 1, pn = L & 1;
        u.A = A + ((size_t)pm * BM * D + (size_t)g * 512) * 2; u.B = B + ((size_t)g * 512 * 512 + (size_t)pn * BM * 512) * 2;
        u.list = nullptr; u.nvalid = 256; u.r0 = pm * BM; u.c0 = g * 512 + pn * BM; u.aux = g; u.pad = 0; return true;
    }
};
struct MoeOrder {
    const LAS int* tab; const char* A; const char* B; const int* seg; int nN, G, c, mode; size_t bstride;
    __device__ __forceinline__ bool next(int i, GUnit& u) const {
        const int cx = (G % 8 == 0) ? (c % 8) * (G / 8) + c / 8 : c;
        const int L = i * G + cx; const int ntile = tab[64 + 64];
        if (L >= ntile * nN) return false;
        const int rtg = L / nN, pn = L % nN;
        int e = 0;
#pragma unroll 1
        for (int j = 32; j >= 1; j >>= 1) if (tab[64 + e + j] <= rtg) e += j;
        const int rt = rtg - tab[64 + e], cnt = tab[e], roff = tab[129 + e];
        u.nvalid = (cnt - rt * BM) < BM ? (cnt - rt * BM) : BM;
        u.list = seg + (size_t)e * SEGCAP + rt * BM;
        u.r0 = roff + rt * BM; u.c0 = pn * BM; u.aux = e; u.pad = 0;
        u.B = B + (size_t)e * bstride + (size_t)pn * BM * (mode == 0 ? D : DFF) * 2;
        u.A = mode == 0 ? A : A + (size_t)(roff + rt * BM) * DFF * 2;
        return true;
    }
};

struct EpiQKV {
    bf16_t* Q; const float* rope;
    __device__ __forceinline__ void operator()(const f32x4 (&acc)[2][2][4][2], const GUnit& u, int wr, int wc, int fr, int fq) const {
        const int region = u.c0 >> 11; bf16_t* base = Q + (size_t)region * ((WS_K - WS_Q) / 2);
        const int col0 = (u.c0 & 2047) + wc * 32 + 4 * fq; const bool rot = (region < 2) && (wc == 0);
        const float qs = region == 0 ? 0.12751743074602334f : 1.0f;
        f32x4 cs[2][4], sn[2][4];
#pragma unroll
        for (int ai = 0; ai < 2; ++ai)
#pragma unroll
            for (int m = 0; m < 4; ++m) { cs[ai][m] = (f32x4){1.f, 1.f, 1.f, 1.f}; sn[ai][m] = (f32x4){0.f, 0.f, 0.f, 0.f}; }
        if (rot) {
#pragma unroll
            for (int ai = 0; ai < 2; ++ai)
#pragma unroll
                for (int m = 0; m < 4; ++m) { const int row = u.r0 + ai * HALF + wr * 64 + m * 16 + fr;
                    cs[ai][m] = *(const f32x4*)(rope + (size_t)row * 32 + 4 * fq); sn[ai][m] = *(const f32x4*)(rope + (size_t)row * 32 + 16 + 4 * fq); }
        }
#pragma unroll
        for (int ai = 0; ai < 2; ++ai)
#pragma unroll
            for (int m = 0; m < 4; ++m) {
                const int row = u.r0 + ai * HALF + wr * 64 + m * 16 + fr;
                bf16_t* rowp = base + (size_t)row * D + col0;
#pragma unroll
                for (int bj = 0; bj < 2; ++bj) {
                    const f32x4 v0 = acc[ai][bj][m][0], v1 = acc[ai][bj][m][1];
                    const f32x4 o0 = (v0 * cs[ai][m] - v1 * sn[ai][m]) * qs, o1 = (v1 * cs[ai][m] + v0 * sn[ai][m]) * qs;
                    u32x2 w0, w1; w0.x = cvtpk(o0[0], o0[1]); w0.y = cvtpk(o0[2], o0[3]); w1.x = cvtpk(o1[0], o1[1]); w1.y = cvtpk(o1[2], o1[3]);
                    *(u32x2*)(rowp + bj * HALF) = w0; *(u32x2*)(rowp + bj * HALF + 16) = w1; }
            }
    }
};
struct EpiMix {
    bf16_t* M; const float* scale;
    __device__ __forceinline__ void operator()(const f32x4 (&acc)[2][2][4][2], const GUnit& u, int wr, int wc, int fr, int fq) const {
        const int col0 = u.c0 + wc * 32 + 4 * fq;
        f32x4 sc[2][2];
#pragma unroll
        for (int bj = 0; bj < 2; ++bj)
#pragma unroll
            for (int n = 0; n < 2; ++n) sc[bj][n] = scale ? *(const f32x4*)(scale + col0 + bj * HALF + n * 16) : (f32x4){1.f, 1.f, 1.f, 1.f};
#pragma unroll
        for (int ai = 0; ai < 2; ++ai)
#pragma unroll
            for (int m = 0; m < 4; ++m) { bf16_t* rowp = M + (size_t)(u.r0 + ai * HALF + wr * 64 + m * 16 + fr) * D + col0;
#pragma unroll
                for (int bj = 0; bj < 2; ++bj)
#pragma unroll
                    for (int n = 0; n < 2; ++n) { const f32x4 o = acc[ai][bj][m][n] * sc[bj][n]; u32x2 w; w.x = cvtpk(o[0], o[1]); w.y = cvtpk(o[2], o[3]); *(u32x2*)(rowp + bj * HALF + n * 16) = w; } }
    }
};
struct EpiMoeIn {
    bf16_t* H;
    __device__ __forceinline__ void operator()(const f32x4 (&acc)[2][2][4][2], const GUnit& u, int wr, int wc, int fr, int fq) const {
        const int col0 = (u.c0 >> 1) + wc * 32 + 4 * fq;
#pragma unroll
        for (int ai = 0; ai < 2; ++ai)
#pragma unroll
            for (int m = 0; m < 4; ++m) {
                const int r = ai * HALF + wr * 64 + m * 16 + fr;
                if (r < u.nvalid) {
                    bf16_t* rowp = H + (size_t)(u.r0 + r) * DFF + col0;
#pragma unroll
                    for (int n = 0; n < 2; ++n) { const f32x4 g = acc[ai][0][m][n], up = acc[ai][1][m][n]; f32x4 o;
#pragma unroll
                        for (int j = 0; j < 4; ++j) o[j] = g[j] * __builtin_amdgcn_rcpf(1.0f + __builtin_amdgcn_exp2f(-1.4426950408889634f * g[j])) * up[j];
                        u32x2 w; w.x = cvtpk(o[0], o[1]); w.y = cvtpk(o[2], o[3]); *(u32x2*)(rowp + n * 16) = w; }
                }
            }
    }
};
struct EpiMoeOut {
    bf16_t* Y; const float* gates;
    __device__ __forceinline__ void operator()(const f32x4 (&acc)[2][2][4][2], const GUnit& u, int wr, int wc, int fr, int fq) const {
        const int col0 = u.c0 + wc * 32 + 4 * fq;
        int slot[2][4]; float g[2][4];
#pragma unroll
        for (int ai = 0; ai < 2; ++ai)
#pragma unroll
            for (int m = 0; m < 4; ++m) { const int r = ai * HALF + wr * 64 + m * 16 + fr; slot[ai][m] = u.list[r < u.nvalid ? r : 0]; }
#pragma unroll
        for (int ai = 0; ai < 2; ++ai)
#pragma unroll
            for (int m = 0; m < 4; ++m) g[ai][m] = gates[slot[ai][m]];
#pragma unroll
        for (int ai = 0; ai < 2; ++ai)
#pragma unroll
            for (int m = 0; m < 4; ++m) {
                const int r = ai * HALF + wr * 64 + m * 16 + fr;
                if (r < u.nvalid) {
                    bf16_t* rowp = Y + (size_t)slot[ai][m] * D + col0;
#pragma unroll
                    for (int bj = 0; bj < 2; ++bj)
#pragma unroll
                        for (int n = 0; n < 2; ++n) { const f32x4 o = acc[ai][bj][m][n] * g[ai][m]; u32x2 w; w.x = cvtpk(o[0], o[1]); w.y = cvtpk(o[2], o[3]); *(u32x2*)(rowp + bj * HALF + n * 16) = w; }
                }
            }
    }
};
}

struct Args { const float* in[13]; float* out; unsigned char* ws; int ph_lo, ph_hi; };
struct Ctx { unsigned char* ws; LAS unsigned char* lds; int G, bid, wv; };
typedef const __attribute__((address_space(4))) Args* KArgs;
__device__ __forceinline__ KArgs kargs() { KArgs p = (KArgs)__builtin_amdgcn_kernarg_segment_ptr(); asm volatile("" : "+s"(p)); return p; }
__device__ __forceinline__ unsigned char* opaque_ws(unsigned char* p) { size_t z = 0; asm volatile("" : "+s"(z)); return as_global(p) + z; }
enum { IN_X = 0, IN_WQKV, IN_LAMBDA, IN_SUBLN, IN_WO, IN_POOLW, IN_POOLSC, IN_ROUTERW, IN_ROUTERB, IN_MOEIN, IN_MOEOUT, IN_LNG, IN_LNB };

constexpr int P0_QKV = 2 * 16 * 48, P0_WO = 2 * 16 * 16, P0_POOL = 8 * 4 * 4, P0_MIN = 256 * 16 * 8, P0_MOUT = 256 * 4 * 16;
__device__ __forceinline__ void p0_decode(int ur, unsigned char* ws, KArgs KA, const float*& src, bf16_t*& dst, int& ldn, int& K) {
    int u = (P0_QKV + P0_WO + P0_POOL + P0_MIN + P0_MOUT - 1) - ur;
    int mat, kt, ntile, n0s, n0d;
    if (u < P0_QKV) { mat = u / 768; const int r = u % 768; kt = r / 48; ntile = r % 48; ldn = 6144; K = 2048; n0s = n0d = ntile * 128;
        src = as_global(KA->in[IN_WQKV]) + (size_t)mat * 2048 * 6144; dst = (bf16_t*)(ws + WS_WQKV) + (size_t)mat * 6144 * 2048; }
    else if ((u -= P0_QKV) < P0_WO) { mat = u / 256; const int r = u % 256; kt = r / 16; ntile = r % 16; ldn = 2048; K = 2048; n0s = n0d = ntile * 128;
        src = as_global(KA->in[IN_WO]) + (size_t)mat * 2048 * 2048; dst = (bf16_t*)(ws + WS_WO) + (size_t)mat * 2048 * 2048; }
    else if ((u -= P0_WO) < P0_POOL) { mat = u / 16; const int r = u % 16; kt = r / 4; ntile = r % 4; ldn = 512; K = 512; n0s = n0d = ntile * 128;
        src = as_global(KA->in[IN_POOLW]) + (size_t)mat * 512 * 512; dst = (bf16_t*)(ws + WS_WPOOL) + (size_t)mat * 512 * 512; }
    else if ((u -= P0_POOL) < P0_MIN) { mat = u / 128; const int r = u % 128; kt = r / 8; ntile = r % 8; ldn = 1024; K = 2048; n0s = ntile * 128;
        { const int bj = n0s >> 9, pn = (n0s & 511) >> 7; n0d = 256 * pn + 128 * bj; }
        src = as_global(KA->in[IN_MOEIN]) + (size_t)mat * 2048 * 1024; dst = (bf16_t*)(ws + WS_WIN) + (size_t)mat * 1024 * 2048; }
    else { u -= P0_MIN; mat = u / 64; const int r = u % 64; kt = r / 16; ntile = r % 16; ldn = 2048; K = 512; n0s = n0d = ntile * 128;
        src = as_global(KA->in[IN_MOEOUT]) + (size_t)mat * 512 * 2048; dst = (bf16_t*)(ws + WS_WOUT) + (size_t)mat * 2048 * 512; }
    src += (size_t)kt * 128 * ldn + n0s; dst += (size_t)n0d * K + kt * 128;
}
constexpr int P0_UNITS = P0_QKV + P0_WO + P0_POOL + P0_MIN + P0_MOUT;
__device__ __forceinline__ void sincos_d(double a, double& s, double& c) {
    const double k = rint(a * 0.63661977236758134308);
    double r = fma(-k, 1.57079632679489655800e+00, a); r = fma(-k, 6.12323399573676603587e-17, r);
    const double r2 = r * r;
    double sp = r2 * (1.0 / 6227020800.0) - 1.0 / 39916800.0; sp = sp * r2 + 1.0 / 362880.0; sp = sp * r2 - 1.0 / 5040.0; sp = sp * r2 + 1.0 / 120.0; sp = sp * r2 - 1.0 / 6.0; sp = sp * r2 * r + r;
    double cp = r2 * (-1.0 / 87178291200.0) + 1.0 / 479001600.0; cp = cp * r2 - 1.0 / 3628800.0; cp = cp * r2 + 1.0 / 40320.0; cp = cp * r2 - 1.0 / 720.0; cp = cp * r2 + 1.0 / 24.0; cp = cp * r2 - 0.5; cp = cp * r2 + 1.0;
    const int q = ((int)k) & 3;
    s = (q == 0) ? sp : (q == 1) ? cp : (q == 2) ? -sp : -cp;
    c = (q == 0) ? cp : (q == 1) ? -sp : (q == 2) ? -cp : sp;
}
__device__ __forceinline__ void p0_convert(const Ctx& F, unsigned char* ws, KArgs KA, int tid, int u_begin, int u_end) {
    LAS unsigned short* T = (LAS unsigned short*)F.lds;
    constexpr int TP = 130;
    const int kr = tid >> 5, nc = (tid & 31) * 4;
    const int on = tid >> 2, ok = (tid & 3) * 32;
    int u = u_begin + F.bid;
    f32x4 v[8];
    const float* src; bf16_t* dst; int ldn, K;
    if (u < u_end) { p0_decode(u, ws, KA, src, dst, ldn, K);
#pragma unroll
        for (int i = 0; i < 8; ++i) v[i] = *(const f32x4*)(src + (size_t)(kr + 16 * i) * ldn + nc); }
    while (u < u_end) {
#pragma unroll
        for (int i = 0; i < 8; ++i) { const int k = kr + 16 * i;
            const unsigned p0 = cvtpk(v[i][0], v[i][1]), p1 = cvtpk(v[i][2], v[i][3]);
            T[(nc + 0) * TP + k] = (unsigned short)(p0 & 0xffff); T[(nc + 1) * TP + k] = (unsigned short)(p0 >> 16);
            T[(nc + 2) * TP + k] = (unsigned short)(p1 & 0xffff); T[(nc + 3) * TP + k] = (unsigned short)(p1 >> 16); }
        bf16_t* cdst = dst; const int cK = K;
        const int un = u + F.G;
        if (un < u_end) { p0_decode(un, ws, KA, src, dst, ldn, K);
#pragma unroll
            for (int i = 0; i < 8; ++i) v[i] = *(const f32x4*)(src + (size_t)(kr + 16 * i) * ldn + nc); }
        __syncthreads();
        { unsigned w[16];
#pragma unroll
          for (int j = 0; j < 16; ++j) w[j] = *(const LAS unsigned*)(T + on * TP + ok + 2 * j);
#pragma unroll
          for (int q = 0; q < 4; ++q) { u32x4 ww = {w[4 * q], w[4 * q + 1], w[4 * q + 2], w[4 * q + 3]}; *(u32x4*)(cdst + (size_t)on * cK + ok + 8 * q) = ww; } }
        __syncthreads();
        u = un;
    }
}
__device__ __forceinline__ void phase_prologue(const Ctx& F) {
    unsigned char* const ws = opaque_ws(F.ws);
    const int tid = phase_tid(); KArgs KA = kargs();
    constexpr int N_MOE_UNITS = P0_MIN + P0_MOUT;
    if (F.G != 256) p0_convert(F, ws, KA, tid, 0, N_MOE_UNITS);
    for (int e = F.bid * NTHREADS + tid; e < S * 16; e += F.G * NTHREADS) {
        const int pos = e >> 4, i = e & 15;
        const float invf = (float)exp2(-(double)i * (18.931568569324174087 / 16.0));
        const float ang = (float)pos * invf;
        double s, c; sincos_d((double)ang, s, c);
        float* rp = (float*)(ws + WS_ROPE) + (size_t)pos * 32; rp[i] = (float)c; rp[16 + i] = (float)s;
    }
    { const float* x = as_global(KA->in[IN_X]); bf16_t* hb = (bf16_t*)(ws + WS_HB);
      for (size_t i = (size_t)F.bid * NTHREADS + tid; i < (size_t)S * D / 8; i += (size_t)F.G * NTHREADS) {
          const f32x4 a = *(const f32x4*)(x + i * 8), b = *(const f32x4*)(x + i * 8 + 4);
          u32x4 w; w.x = cvtpk(a[0], a[1]); w.y = cvtpk(a[2], a[3]); w.z = cvtpk(b[0], b[1]); w.w = cvtpk(b[2], b[3]);
          *(u32x4*)(hb + i * 8) = w; } }
    { const float* rw = as_global(KA->in[IN_ROUTERW]); bf16_t* rth = (bf16_t*)(ws + WS_RT); bf16_t* rtl = rth + NE * D;
      for (int i = F.bid * NTHREADS + tid; i < D * NE; i += F.G * NTHREADS) { const int k = i >> 6, e = i & 63; const float x = rw[i];
          const unsigned h = cvtpk(x, 0.f) & 0xffffu; const float r = x - __uint_as_float(h << 16); const unsigned l = cvtpk(r, 0.f) & 0xffffu;
          rth[e * D + k] = (bf16_t)h; rtl[e * D + k] = (bf16_t)l; } }
    __syncthreads();
    p0_convert(F, ws, KA, tid, N_MOE_UNITS, P0_UNITS);
}

namespace att {
constexpr int KVBLK = 64;
constexpr int SHM_K = KVBLK * HD * 2  , SHM_V = KVBLK * VD * 2  ;
constexpr int OFF_K = 0, OFF_V = 2 * SHM_K;
#define KSWZ(row, colB) ((row) * 256 + ((colB) ^ (((row) & 15) << 4)))
__device__ __forceinline__ int crow(int r, int hi) { return (r & 3) + 8 * (r >> 2) + 4 * hi; }
__device__ __forceinline__ int v_st(int k, int c) { const int kk = (k & ~0xC) | ((k & 4) << 1) | ((k & 8) >> 1); return ((kk >> 3) * 8 + (c >> 5)) * 512 + ((kk & 7) * 32 + (c & 31)) * 2; }
__device__ __forceinline__ int v_rd_base(int lane) { return ((lane & 3) << 3) | (((lane >> 2) & 3) << 6) | (((lane >> 4) & 1) << 5) | (((lane >> 5) & 1) << 8); }
constexpr int v_rd_off(int d0, int ks, int half) { return d0 * 512 + ks * 8192 + half * 4096; }
template <int OFF> __device__ __forceinline__ s16x4 tr_read(int vb) {
    s16x4 r; asm volatile("ds_read_b64_tr_b16 %0, %1 offset:%2" : "=&v"(r) : "v"(vb), "i"(OFF) : "memory"); return r;
}
template <int OFF> __device__ __forceinline__ bf16x8 lds_read128(int a) {
    bf16x8 r; asm volatile("ds_read_b128 %0, %1 offset:%2" : "=&v"(r) : "v"(a), "i"(OFF) : "memory"); return r;
}
template <int OFF> __device__ __forceinline__ void lds_write128(int a, u32x4 v) {
    asm volatile("ds_write_b128 %0, %1 offset:%2" :: "v"(a), "v"(v), "i"(OFF) : "memory");
}
#define PKV(L, H) (bf16x8){L[0], L[1], L[2], L[3], H[0], H[1], H[2], H[3]}
#define WAIT_LGKM(n) do { asm volatile("s_waitcnt lgkmcnt(" #n ")" ::: "memory"); SBAR(); } while (0)
#define PV_RD(R, D0, H) do { R##0 = tr_read<v_rd_off(D0, 2 * (H), 0)>(vb); R##1 = tr_read<v_rd_off(D0, 2 * (H), 1)>(vb); R##2 = tr_read<v_rd_off(D0, 2 * (H) + 1, 0)>(vb); R##3 = tr_read<v_rd_off(D0, 2 * (H) + 1, 1)>(vb); } while (0)
#define PV_MM(R, D0, PA, PB) do { o[D0] = __builtin_amdgcn_mfma_f32_32x32x16_bf16(PA, PKV(R##0, R##1), o[D0], 0, 0, 0); o[D0] = __builtin_amdgcn_mfma_f32_32x32x16_bf16(PB, PKV(R##2, R##3), o[D0], 0, 0, 0); SBAR(); } while (0)
template <int D_LO> __device__ __forceinline__ void pv_quad(f32x16 (&o)[8], int vb, const bf16x8& pa0, const bf16x8& pa1, const bf16x8& pa2, const bf16x8& pa3) {
    s16x4 A0, A1, A2, A3, B0, B1, B2, B3;
    PV_RD(A, D_LO + 0, 0); PV_RD(B, D_LO + 0, 1);
    WAIT_LGKM(4); PV_MM(A, D_LO + 0, pa0, pa1); PV_RD(A, D_LO + 1, 0);
    WAIT_LGKM(4); PV_MM(B, D_LO + 0, pa2, pa3); PV_RD(B, D_LO + 1, 1);
    WAIT_LGKM(4); PV_MM(A, D_LO + 1, pa0, pa1); PV_RD(A, D_LO + 2, 0);
    WAIT_LGKM(4); PV_MM(B, D_LO + 1, pa2, pa3); PV_RD(B, D_LO + 2, 1);
    WAIT_LGKM(4); PV_MM(A, D_LO + 2, pa0, pa1); PV_RD(A, D_LO + 3, 0);
    WAIT_LGKM(4); PV_MM(B, D_LO + 2, pa2, pa3); PV_RD(B, D_LO + 3, 1);
    WAIT_LGKM(4); PV_MM(A, D_LO + 3, pa0, pa1);
    WAIT_LGKM(0); PV_MM(B, D_LO + 3, pa2, pa3);
}
#define QK_RD(R, KB, DH) do { R##0 = lds_read128<(DH) * 128>(KB); R##1 = lds_read128<(DH) * 128 + 8192>(KB); } while (0)
#define QK_MM(R, Q) do { p0 = __builtin_amdgcn_mfma_f32_32x32x16_bf16(R##0, Q, p0, 0, 0, 0); p1 = __builtin_amdgcn_mfma_f32_32x32x16_bf16(R##1, Q, p1, 0, 0, 0); SBAR(); } while (0)
__device__ __forceinline__ void qk_tile(f32x16& p0, f32x16& p1, int k0, int k1, int k2, int k3, const bf16x8 (&qr)[8]) {
    bf16x8 A0, A1, B0, B1;
    QK_RD(A, k0, 0); QK_RD(B, k1, 0);
    WAIT_LGKM(2); QK_MM(A, qr[0]); QK_RD(A, k2, 0);
    WAIT_LGKM(2); QK_MM(B, qr[1]); QK_RD(B, k3, 0);
    WAIT_LGKM(2); QK_MM(A, qr[2]); QK_RD(A, k0 ^ 128, 0);
    WAIT_LGKM(2); QK_MM(B, qr[3]); QK_RD(B, k1 ^ 128, 0);
    WAIT_LGKM(2); QK_MM(A, qr[4]); QK_RD(A, k2 ^ 128, 0);
    WAIT_LGKM(2); QK_MM(B, qr[5]); QK_RD(B, k3 ^ 128, 0);
    WAIT_LGKM(2); QK_MM(A, qr[6]);
    WAIT_LGKM(0); QK_MM(B, qr[7]);
}
constexpr float THR_UP = 11.5f, THR_DN = 40.f;
__device__ __forceinline__ void softmax_tile(f32x16& p0, f32x16& p1, float& m_reg, float& l_reg, bool& mz, float& alpha, bf16x8& pa0, bf16x8& pa1, bf16x8& pa2, bf16x8& pa3) {
    float pmax = p0[0];
#pragma unroll
    for (int r = 1; r < 16; ++r) pmax = fmaxf(pmax, p0[r]);
#pragma unroll
    for (int r = 0; r < 16; ++r) pmax = fmaxf(pmax, p1[r]);
    { auto rr = __builtin_amdgcn_permlane32_swap(__float_as_uint(pmax), __float_as_uint(pmax), false, false);
      pmax = fmaxf(__uint_as_float(rr[0]), __uint_as_float(rr[1])); }
    const bool ok = (pmax <= THR_UP) && (pmax >= -THR_DN);
    alpha = 1.f;
    if (__builtin_expect(!__all(ok), 0)) {
        const float dlt = ok ? 0.f : fmaxf(pmax, -120.f);
        alpha = __builtin_amdgcn_exp2f(-dlt); m_reg += dlt; mz = __all(m_reg == 0.f);
#pragma unroll
        for (int r = 0; r < 16; ++r) { p0[r] -= dlt; p1[r] -= dlt; }
    }
#pragma unroll
    for (int r = 0; r < 16; ++r) { p0[r] = __builtin_amdgcn_exp2f(p0[r]); p1[r] = __builtin_amdgcn_exp2f(p1[r]); }
    float ps = 0;
#pragma unroll
    for (int r = 0; r < 16; ++r) ps += p0[r];
#pragma unroll
    for (int r = 0; r < 16; ++r) ps += p1[r];
    { auto rr = __builtin_amdgcn_permlane32_swap(__float_as_uint(ps), __float_as_uint(ps), false, false);
      ps = __uint_as_float(rr[0]) + __uint_as_float(rr[1]); }
    l_reg = l_reg * alpha + ps;
#define PK4(P, BASE, OUT) do { unsigned a0 = cvtpk(P[BASE + 0], P[BASE + 1]), a1 = cvtpk(P[BASE + 2], P[BASE + 3]);   \
    unsigned b0 = cvtpk(P[BASE + 4], P[BASE + 5]), b1 = cvtpk(P[BASE + 6], P[BASE + 7]);                              \
    auto r0 = __builtin_amdgcn_permlane32_swap(a0, b0, false, false); auto r1 = __builtin_amdgcn_permlane32_swap(a1, b1, false, false); \
    u32x4 w = {r0[0], r1[0], r0[1], r1[1]}; OUT = *reinterpret_cast<bf16x8*>(&w); } while (0)
    PK4(p0, 0, pa0); PK4(p0, 8, pa1); PK4(p1, 0, pa2); PK4(p1, 8, pa3);
#undef PK4
}

template <bool BG> __device__ __forceinline__ void attn_unit(const Ctx& F, const bf16_t* Qg, const bf16_t* Kg, const bf16_t* Vg, bf16_t* AO, const float* subg, float lam, float outscale, int h, int qb, int bgpass0) {
    unsigned char* const ws = opaque_ws(F.ws);
    const int ldsb = (int)(uintptr_t)F.lds;
    const int tid = phase_tid(), wid = __builtin_amdgcn_readfirstlane(tid >> 6), lane = tid & 63, r32 = lane & 31, hi = lane >> 5;
    const int grp = wid >> 2;
    LAS float* wsf = (LAS float*)(F.lds + LDS_MISC + 1024) + wid * 64;
    LAS float* li_l = wsf; LAS float* al_l = wsf + 32;
    constexpr int NT = S / KVBLK;
    const int ta = tid & 255;
    const __amdgpu_buffer_rsrc_t rW = __builtin_amdgcn_make_buffer_rsrc((void*)ws, 0, 0xFFFFFFFFu, 0x00020000);
    const int wK = ldsb + OFF_K + KSWZ(ta >> 4, (ta & 15) * 16);
    const int wV = ldsb + OFF_V + v_st(ta >> 5, (ta & 31) * 8);
    const int vrd = ldsb + OFF_V + v_rd_base(lane);
    const int x15 = (r32 & 15) << 4;
    for (int comp = 0; comp < 2; ++comp) {
        const int voQ = ((qb * 256 + wid * 32 + r32) * D + h * 256 + comp * 128 + hi * 8) * 2;
        const int voK = (((ta >> 4) * D) + h * 256 + comp * 128 + (ta & 15) * 8) * 2;
        const int voV = (((ta >> 5) * D) + h * 256 + (ta & 31) * 8) * 2;
        bf16x8 qr[8];
#pragma unroll
        for (int d0 = 0; d0 < 8; ++d0) { const u32x4 qv = __builtin_amdgcn_raw_buffer_load_b128(rW, voQ, (int)(unsigned)WS_Q + d0 * 32, 0); qr[d0] = *reinterpret_cast<const bf16x8*>(&qv); }
        f32x16 o[8];
#pragma unroll
        for (int d = 0; d < 8; ++d) o[d] = f32x16{};
        float m_reg = 0.f, l_reg = 0.f; bool mz = true;
        const int bgpass = bgpass0 + comp;
        const int bgm = !BG ? 0 : bgpass < 2 ? 1 : bgpass == 2 ? 2 : 0;
        const int bgN = bgm == 1 ? 1024 : 2048, bgK = bgm == 1 ? 2048 : 512;
        const float* bgsrc = as_global(kargs()->in[IN_MOEIN]); unsigned bgdst = 0;
        LAS unsigned char* const bgl = F.lds + 98304 + wid * 2048;
        if (bgm == 1) { const int n0 = (F.bid & 31) * 32, nd = 256 * ((n0 & 511) >> 7) + 128 * (n0 >> 9) + (n0 & 127);
            bgsrc = as_global(kargs()->in[IN_MOEIN]) + (size_t)bgpass * 256 * 1048576 + (F.bid >> 5) * 131072 + wid * 16384 + n0;
            bgdst = (unsigned)WS_WIN + (unsigned)bgpass * (128u * 2097152u * 2u) + (unsigned)(nd * 2048 + (F.bid >> 5) * 128 + wid * 16) * 2u; }
        else if (bgm == 2) { const int n0 = (F.bid & 63) * 32;
            bgsrc = as_global(kargs()->in[IN_MOEOUT]) + (F.bid >> 6) * (128 * 2048) + wid * (16 * 2048) + n0;
            bgdst = (unsigned)WS_WOUT + (unsigned)(n0 * 512 + (F.bid >> 6) * 128 + wid * 16) * 2u; }
        const unsigned long long bgp_ = (unsigned long long)(uintptr_t)bgsrc;
        const unsigned bgp0 = __builtin_amdgcn_readfirstlane((unsigned)bgp_), bgp1 = __builtin_amdgcn_readfirstlane((unsigned)(bgp_ >> 32)), bgnr = __builtin_amdgcn_readfirstlane(bgm ? 0xFFFFFFFFu : 0u);
#define BG_RSRC() __builtin_amdgcn_make_buffer_rsrc((void*)(uintptr_t)(((unsigned long long)(unsigned)__builtin_amdgcn_readfirstlane(bgp1) << 32) | (unsigned long long)(unsigned)__builtin_amdgcn_readfirstlane(bgp0)), 0, __builtin_amdgcn_readfirstlane(bgnr), 0x00020000)
#define BG_ISSUE(t) do { if constexpr (BG) { int lq = lane; asm volatile("" : "+v"(lq)); int lb_ = (int)(uintptr_t)bgl; asm volatile("" : "+s"(lb_)); \
            const int vo_ = ((lq >> 3) * bgN + 4 * (lq & 7)) * 4; const int so_ = (t) * 4194304; \
            const __amdgpu_buffer_rsrc_t rB_ = BG_RSRC(); \
            __builtin_amdgcn_raw_ptr_buffer_load_lds(rB_, (LAS void*)(uintptr_t)lb_, 16, vo_, so_, 0, 0); \
            __builtin_amdgcn_raw_ptr_buffer_load_lds(rB_, (LAS void*)(uintptr_t)(lb_ + 1024), 16, vo_, so_ + 32 * bgN, 0, 0); } } while (0)
#define BG_CONSUME(t) do { if constexpr (BG) { { int lq = lane; asm volatile("" : "+v"(lq)); \
            const LAS float* rp_ = (const LAS float*)(bgl + (lq >> 5) * 1024 + (lq & 31) * 4); \
            float x_[8]; _Pragma("unroll") for (int i_ = 0; i_ < 8; ++i_) x_[i_] = rp_[i_ * 32]; \
            u32x4 w_; w_.x = cvtpk(x_[0], x_[1]); w_.y = cvtpk(x_[2], x_[3]); w_.z = cvtpk(x_[4], x_[5]); w_.w = cvtpk(x_[6], x_[7]); \
            const int do_ = bgdst + (bgm == 1 ? ((t) >> 1) * 4194304 + ((t) & 1) * 2048 : (t) * 2097152); \
            const __amdgpu_buffer_rsrc_t rS_ = __builtin_amdgcn_make_buffer_rsrc((void*)(uintptr_t)(((unsigned long long)(unsigned)__builtin_amdgcn_readfirstlane(wsh_) << 32) | (unsigned long long)(unsigned)__builtin_amdgcn_readfirstlane(wsl_)), 0, __builtin_amdgcn_readfirstlane(bgnr), 0x00020000); \
            __builtin_amdgcn_raw_buffer_store_b128(w_, rS_, ((lq & 31) * bgK + (lq >> 5) * 8) * 2, do_, 0); SBAR(); } } } while (0)
        u32x4 st[3];
#define ST_LOAD0(t) do { const int sb = (t) * (KVBLK * D * 2); \
        if (grp == 0) { _Pragma("unroll") for (int i = 0; i < 3; ++i) st[i] = __builtin_amdgcn_raw_buffer_load_b128(rW, voK, (int)(unsigned)WS_K + sb + i * (16 * D * 2), 0); } \
        else { _Pragma("unroll") for (int i = 0; i < 3; ++i) st[i] = __builtin_amdgcn_raw_buffer_load_b128(rW, voV, (int)(unsigned)WS_V + sb + (i + 2) * (8 * D * 2), 0); } } while (0)
#define ST_LOAD1(t) do { const int sb = (t) * (KVBLK * D * 2); \
        if (grp == 0) { st[0] = __builtin_amdgcn_raw_buffer_load_b128(rW, voK, (int)(unsigned)WS_K + sb + 3 * (16 * D * 2), 0); \
                        st[1] = __builtin_amdgcn_raw_buffer_load_b128(rW, voV, (int)(unsigned)WS_V + sb, 0); st[2] = __builtin_amdgcn_raw_buffer_load_b128(rW, voV, (int)(unsigned)WS_V + sb + 8 * D * 2, 0); } \
        else { _Pragma("unroll") for (int i = 0; i < 3; ++i) st[i] = __builtin_amdgcn_raw_buffer_load_b128(rW, voV, (int)(unsigned)WS_V + sb + (i + 5) * (8 * D * 2), 0); } } while (0)
        const unsigned wsl_ = (unsigned)(uintptr_t)ws, wsh_ = (unsigned)((unsigned long long)(uintptr_t)ws >> 32);
#define ST_WRITE0(b) do { const int wk = wK + (b) * SHM_K, wv = wV + (b) * SHM_V; \
        if (grp == 0) { lds_write128<0>(wk, st[0]); lds_write128<4096>(wk, st[1]); lds_write128<8192>(wk, st[2]); } \
        else { lds_write128<8192>(wv, st[0]); lds_write128<8192 + 256>(wv, st[1]); lds_write128<16384>(wv, st[2]); } } while (0)
#define ST_WRITE1(b) do { const int wk = wK + (b) * SHM_K, wv = wV + (b) * SHM_V; \
        if (grp == 0) { lds_write128<12288>(wk, st[0]); lds_write128<0>(wv, st[1]); lds_write128<256>(wv, st[2]); } \
        else { lds_write128<16384 + 256>(wv, st[0]); lds_write128<24576>(wv, st[1]); lds_write128<24576 + 256>(wv, st[2]); } } while (0)
        { u32x4 keep0, keep1, keep2;
          ST_LOAD0(0); keep0 = st[0]; keep1 = st[1]; keep2 = st[2]; ST_LOAD1(0);
          { u32x4 t0 = st[0], t1 = st[1], t2 = st[2]; st[0] = keep0; st[1] = keep1; st[2] = keep2; ST_WRITE0(0); st[0] = t0; st[1] = t1; st[2] = t2; ST_WRITE1(0); } }
        LGKM_WAIT0(); __syncthreads();
        BG_ISSUE(0);
        if (grp == 1) __builtin_amdgcn_s_barrier();
#pragma unroll 1
        for (int t = 0; t < NT; ++t) {
            const int b = t & 1;
            const int tn = t + 1 < NT ? t + 1 : NT - 1;
            ST_LOAD0(tn);
            f32x16 p0 = f32x16{}, p1 = f32x16{}; float alpha; bf16x8 pa0, pa1, pa2, pa3;
            { const int kbuf = ldsb + OFF_K + b * SHM_K + r32 * 256;
              const int k0 = kbuf + ((0 * 32 + hi * 16) ^ x15), k1 = kbuf + ((1 * 32 + hi * 16) ^ x15), k2 = kbuf + ((2 * 32 + hi * 16) ^ x15), k3 = kbuf + ((3 * 32 + hi * 16) ^ x15);
              __builtin_amdgcn_s_setprio(2);
              if (mz) { qk_tile(p0, p1, k0, k1, k2, k3, qr); }
              else {
#pragma unroll
                  for (int r = 0; r < 16; ++r) { p0[r] = -m_reg; p1[r] = -m_reg; }
                  qk_tile(p0, p1, k0, k1, k2, k3, qr); }
              __builtin_amdgcn_s_setprio(0); }
            if constexpr (BG) { asm volatile("s_waitcnt vmcnt(3)" ::: "memory"); BG_CONSUME(t); }
            softmax_tile(p0, p1, m_reg, l_reg, mz, alpha, pa0, pa1, pa2, pa3);
            if (__any(alpha != 1.f)) { if (hi == 0) al_l[r32] = alpha; LGKM_WAIT0();
#pragma unroll
                for (int r = 0; r < 16; ++r) { const float a = al_l[crow(r, hi)];
#pragma unroll
                    for (int d = 0; d < 8; ++d) o[d][r] *= a; } }
            LGKM_WAIT0(); __builtin_amdgcn_s_barrier(); SBAR();
            const int vb = vrd + b * SHM_V;
            ST_WRITE0(b ^ 1); ST_LOAD1(tn); BG_ISSUE(tn);
            __builtin_amdgcn_s_setprio(1);
            pv_quad<0>(o, vb, pa0, pa1, pa2, pa3);
            pv_quad<4>(o, vb, pa0, pa1, pa2, pa3);
            __builtin_amdgcn_s_setprio(0);
            ST_WRITE1(b ^ 1);
            LGKM_WAIT0(); __builtin_amdgcn_s_barrier(); SBAR();
        }
        if (grp == 0) __builtin_amdgcn_s_barrier();
        if constexpr (BG) { VM_WAIT0(); }
#undef BG_ISSUE
#undef BG_RSRC
#undef BG_CONSUME
#undef ST_LOAD0
#undef ST_LOAD1
#undef ST_WRITE0
#undef ST_WRITE1
        if (hi == 0) li_l[r32] = l_reg; LGKM_WAIT0();
        const int voS = F.bid * (128 * 512 * 4) + tid * 4;
        if (comp == 0) {
#pragma unroll
            for (int r = 0; r < 16; ++r) { const float rl = __builtin_amdgcn_rcpf(li_l[crow(r, hi)]);
#pragma unroll
                for (int d = 0; d < 8; ++d) __builtin_amdgcn_raw_buffer_store_b32(__float_as_uint(o[d][r] * rl), rW, voS, (int)(unsigned)WS_OSCR + (d * 16 + r) * 2048, 0);
                SBAR(); }
        } else {
            const int vo = ((qb * 256 + wid * 32 + 4 * hi) * D + h * 256 + r32) * 2;
            const __amdgpu_buffer_rsrc_t rG = __builtin_amdgcn_make_buffer_rsrc((void*)subg, 0, VD * 4, 0x00020000);
            float gsub[8];
#pragma unroll
            for (int d = 0; d < 8; ++d) gsub[d] = __uint_as_float(__builtin_amdgcn_raw_buffer_load_b32(rG, r32 * 4, d * 128, 0));
            float ld[4][8], nx[4][8];
#define O0_LOAD(DST, G) do { _Pragma("unroll") for (int rr = 0; rr < 4; ++rr) _Pragma("unroll") for (int d = 0; d < 8; ++d) \
                DST[rr][d] = __uint_as_float(__builtin_amdgcn_raw_buffer_load_b32(rW, voS, (int)(unsigned)WS_OSCR + (d * 16 + 4 * (G) + rr) * 2048, 0)); } while (0)
            O0_LOAD(ld, 0);
#pragma unroll
            for (int g4 = 0; g4 < 4; ++g4) {
                if (g4 + 1 < 4) O0_LOAD(nx, g4 + 1);
                SBAR();
#pragma unroll
                for (int rr = 0; rr < 4; ++rr) { const int r = 4 * g4 + rr; const float rl = __builtin_amdgcn_rcpf(li_l[crow(r, hi)]) * lam; float acc = 0.f; float v[8];
#pragma unroll
                    for (int d = 0; d < 8; ++d) { v[d] = ld[rr][d] - o[d][r] * rl; acc += v[d] * v[d]; }
                    acc += __int_as_float(__builtin_amdgcn_ds_swizzle(__float_as_int(acc), 0x041F)); acc += __int_as_float(__builtin_amdgcn_ds_swizzle(__float_as_int(acc), 0x081F));
                    acc += __int_as_float(__builtin_amdgcn_ds_swizzle(__float_as_int(acc), 0x101F)); acc += __int_as_float(__builtin_amdgcn_ds_swizzle(__float_as_int(acc), 0x201F));
                    acc += __int_as_float(__builtin_amdgcn_ds_swizzle(__float_as_int(acc), 0x401F));
                    const float sc = __builtin_amdgcn_rsqf(acc * (1.0f / 256.0f) + RMS_EPS) * outscale;
#pragma unroll
                    for (int d = 0; d < 8; ++d) { const unsigned w = cvtpk(v[d] * sc * gsub[d], 0.f);
                        __builtin_amdgcn_raw_buffer_store_b16((short)(w & 0xffff), rW, vo, (int)(unsigned)WS_AO + (((r & 3) + 8 * (r >> 2)) * D + d * 32) * 2, 0); } }
                SBAR();
#pragma unroll
                for (int rr = 0; rr < 4; ++rr)
#pragma unroll
                    for (int d = 0; d < 8; ++d) ld[rr][d] = nx[rr][d];
            }
#undef O0_LOAD
        }
        __syncthreads();
    }
}
}

__device__ __forceinline__ void phase_attention(const Ctx& F, int j) {
    unsigned char* const ws = opaque_ws(F.ws);
    const int lane0 = phase_tid() & 63;
    const __amdgpu_buffer_rsrc_t rL = __builtin_amdgcn_make_buffer_rsrc((void*)(as_global(kargs()->in[IN_LAMBDA]) + (size_t)j * 4 * HD), 0, 4 * HD * 4, 0x00020000);
#define LF(i) __uint_as_float(__builtin_amdgcn_raw_buffer_load_b32(rL, lane0 * 4, (i) * 4, 0))
    float a = LF(0) * LF(HD) + LF(64) * LF(HD + 64);
    float b = LF(2 * HD) * LF(3 * HD) + LF(2 * HD + 64) * LF(3 * HD + 64);
#undef LF
    a = wave_sum(a); b = wave_sum(b);
    const float lam_init = (j == 0) ? 0.2f : 0.47071302f;
    const float lam = expf(a) - expf(b) + lam_init;
    const bf16_t* Q = (const bf16_t*)(ws + WS_Q); const bf16_t* K = (const bf16_t*)(ws + WS_K); const bf16_t* V = (const bf16_t*)(ws + WS_V);
    bf16_t* AO = (bf16_t*)(ws + WS_AO);
    const float* subg = as_global(kargs()->in[IN_SUBLN]) + (size_t)j * VD;
    if (j == 0 && F.G == 256) {
        int ui = 0;
        for (int u = F.bid; u < NH * (S / 256); u += F.G, ++ui) { const int h = u & 7, qb = u >> 3; att::attn_unit<true>(F, Q, K, V, AO, subg, lam, 1.0f - lam_init, h, qb, ui * 2); }
    } else {
        for (int u = F.bid; u < NH * (S / 256); u += F.G) { const int h = u & 7, qb = u >> 3; att::attn_unit<false>(F, Q, K, V, AO, subg, lam, 1.0f - lam_init, h, qb, 0); }
    }
}

__device__ __forceinline__ void phase_route(const Ctx& F, int layer, bool commit, int mode) {
    unsigned char* const ws = opaque_ws(F.ws);
    const bf16_t* MIX = (const bf16_t*)(ws + WS_Z); bf16_t* H1B = (bf16_t*)(ws + WS_H1B);
    KArgs KA = kargs(); const float* router_b = as_global(KA->in[IN_ROUTERB]);
    const bf16_t* Hs = (const bf16_t*)(ws + WS_HB);
    const float* g = as_global(KA->in[IN_LNG]) + (size_t)(layer * 2 + 0) * D; const float* bta = as_global(KA->in[IN_LNB]) + (size_t)(layer * 2 + 0) * D;
    int* cnt = (int*)(ws + WS_CTL + CTL_CNT) + layer * 64; int* seg = (int*)(ws + WS_SEG); float* gates = (float*)(ws + WS_GATE);
    const int tid = phase_tid(); const int lane = tid & 63, wid = __builtin_amdgcn_readfirstlane(tid >> 6);
    LAS float* lgp = (LAS float*)(F.lds);
    for (int tile = F.bid; tile < S / 64; tile += F.G) {
        const int tb = tile * 64;
        if (mode != 2) {
            f32x4 v[8]; u32x4 hq3[3][4], mq3[3][4];
#define RT_LOAD(V, MX, R) do { const bf16_t* hr_ = Hs + (size_t)(R) * D + lane * 8; const bf16_t* mr_ = MIX + (size_t)(R) * D + lane * 8; \
            _Pragma("unroll") for (int i = 0; i < 4; ++i) { V[i] = *(const u32x4*)(hr_ + 512 * i); MX[i] = *(const u32x4*)(mr_ + 512 * i); } } while (0)
            RT_LOAD(hq3[0], mq3[0], tb + wid * 8); RT_LOAD(hq3[1], mq3[1], tb + wid * 8 + 1);
            f32x4 gg[8], bb[8];
#pragma unroll
            for (int i = 0; i < 4; ++i) { gg[2 * i] = *(const f32x4*)(g + lane * 8 + 512 * i); gg[2 * i + 1] = *(const f32x4*)(g + lane * 8 + 512 * i + 4);
                bb[2 * i] = *(const f32x4*)(bta + lane * 8 + 512 * i); bb[2 * i + 1] = *(const f32x4*)(bta + lane * 8 + 512 * i + 4); }
#pragma unroll
            for (int r = 0; r < 8; ++r) {
                const int row = tb + wid * 8 + r;
                if (r + 2 < 8) RT_LOAD(hq3[(r + 2) % 3], mq3[(r + 2) % 3], row + 2);
#pragma unroll
                for (int i = 0; i < 4; ++i) { const u32x4 p = mq3[r % 3][i]; f32x4 m0, m1;
                    m0[0] = __uint_as_float(p.x << 16); m0[1] = __uint_as_float(p.x & 0xffff0000u); m0[2] = __uint_as_float(p.y << 16); m0[3] = __uint_as_float(p.y & 0xffff0000u);
                    m1[0] = __uint_as_float(p.z << 16); m1[1] = __uint_as_float(p.z & 0xffff0000u); m1[2] = __uint_as_float(p.w << 16); m1[3] = __uint_as_float(p.w & 0xffff0000u);
                    const u32x4 hq = hq3[r % 3][i]; f32x4 x0, x1;
                    x0[0] = __uint_as_float(hq.x << 16); x0[1] = __uint_as_float(hq.x & 0xffff0000u); x0[2] = __uint_as_float(hq.y << 16); x0[3] = __uint_as_float(hq.y & 0xffff0000u);
                    x1[0] = __uint_as_float(hq.z << 16); x1[1] = __uint_as_float(hq.z & 0xffff0000u); x1[2] = __uint_as_float(hq.w << 16); x1[3] = __uint_as_float(hq.w & 0xffff0000u);
                    v[2 * i] = x0 * ALPHA + m0; v[2 * i + 1] = x1 * ALPHA + m1; }
                float s = 0.f;
#pragma unroll
                for (int i = 0; i < 8; ++i) s += (v[i][0] + v[i][1]) + (v[i][2] + v[i][3]);
                const float mu = wave_sum(s) * (1.0f / D);
                float q = 0.f;
#pragma unroll
                for (int i = 0; i < 8; ++i) { const f32x4 d = v[i] - mu; q += (d[0] * d[0] + d[1] * d[1]) + (d[2] * d[2] + d[3] * d[3]); }
                const float rstd = __builtin_amdgcn_rsqf(wave_sum(q) * (1.0f / D) + LN_EPS);
                bf16_t* hb = H1B + (size_t)row * D + lane * 8;
#pragma unroll
                for (int i = 0; i < 4; ++i) {
                    const f32x4 g0 = gg[2 * i], g1 = gg[2 * i + 1], b0 = bb[2 * i], b1 = bb[2 * i + 1];
                    const f32x4 y0 = (v[2 * i] - mu) * rstd * g0 + b0, y1 = (v[2 * i + 1] - mu) * rstd * g1 + b1;
                    u32x4 w; w.x = cvtpk(y0[0], y0[1]); w.y = cvtpk(y0[2], y0[3]); w.z = cvtpk(y1[0], y1[1]); w.w = cvtpk(y1[2], y1[3]);
                    *(u32x4*)(hb + 512 * i) = w; }
                SBAR();
            }
#undef RT_LOAD
        }
        VM_WAIT0(); __syncthreads();
        if (mode == 1) continue;
        {
            constexpr int ROWB = 272, HALFB = 64 * ROWB, BUFB = 2 * HALFB;
            LAS unsigned char* Bs = F.lds + 32768;
            const int tg = wid & 3, eh = wid >> 2;
            f32x4 acc[2] = {(f32x4){0.f, 0.f, 0.f, 0.f}, (f32x4){0.f, 0.f, 0.f, 0.f}};
            const bf16_t* aph = H1B + (size_t)(tb + tg * 16 + (lane & 15)) * D + 8 * (lane >> 4);
            const int st_hl = tid >> 8, st_e = (tid >> 2) & 63, st_p = tid & 3;
            const bf16_t* sp = (const bf16_t*)(ws + WS_RT) + (size_t)(st_hl * NE + st_e) * D + st_p * 32;
            const int st_off = st_hl * HALFB + st_e * ROWB + st_p * 64;
            const int rd_off = (32 * eh + (lane & 15)) * ROWB + (lane >> 4) * 16;
            u32x4 bst[4]; u32x4 a0[4], n0[4];
#pragma unroll
            for (int j = 0; j < 4; ++j) bst[j] = *(const u32x4*)(sp + 8 * j);
#pragma unroll
            for (int i = 0; i < 4; ++i) { a0[i] = *(const u32x4*)(aph + 32 * i); }
#pragma unroll
            for (int j = 0; j < 4; ++j) *(LAS u32x4*)(Bs + st_off + 16 * j) = bst[j];
            __syncthreads();
#pragma unroll 1
            for (int c = 0; c < 16; ++c) {
                const int cn = c + 1 < 16 ? c + 1 : c;
#pragma unroll
                for (int j = 0; j < 4; ++j) bst[j] = *(const u32x4*)(sp + cn * 128 + 8 * j);
#pragma unroll
                for (int i = 0; i < 4; ++i) { n0[i] = *(const u32x4*)(aph + cn * 128 + 32 * i); }
                LAS unsigned char* Bc = Bs + (c & 1) * BUFB + rd_off;
#pragma unroll
                for (int i = 0; i < 4; ++i) {
                    const bf16x8 ah = *reinterpret_cast<const bf16x8*>(&a0[i]);
#pragma unroll
                    for (int nb = 0; nb < 2; ++nb) {
                        const bf16x8 bh = *(const LAS bf16x8*)(Bc + nb * 16 * ROWB + i * 64), bl = *(const LAS bf16x8*)(Bc + HALFB + nb * 16 * ROWB + i * 64);
                        acc[nb] = __builtin_amdgcn_mfma_f32_16x16x32_bf16(ah, bh, acc[nb], 0, 0, 0);
                        acc[nb] = __builtin_amdgcn_mfma_f32_16x16x32_bf16(ah, bl, acc[nb], 0, 0, 0); }
                }
#pragma unroll
                for (int j = 0; j < 4; ++j) *(LAS u32x4*)(Bs + ((c + 1) & 1) * BUFB + st_off + 16 * j) = bst[j];
#pragma unroll
                for (int i = 0; i < 4; ++i) { a0[i] = n0[i]; }
                __syncthreads();
            }
            LAS float* lg = lgp + tg * (16 * 64);
#pragma unroll
            for (int nb = 0; nb < 2; ++nb)
#pragma unroll
                for (int rg = 0; rg < 4; ++rg) lg[(4 * (lane >> 4) + rg) * 64 + 32 * eh + 16 * nb + (lane & 15)] = acc[nb][rg];
        }
        LGKM_WAIT0(); __syncthreads();
        if (commit) {
            const int T = tid >> 3, gi = tid & 7; const int tok = tb + T;
            const LAS float* r0 = lgp + (T >> 4) * (16 * 64) + (T & 15) * 64 + gi * 8;
            float m1 = -1e30f, m2 = -1e30f, r1 = 0.f, r2 = 0.f; int i1 = 0, i2 = 0;
#pragma unroll
            for (int e = 0; e < 8; ++e) { const float sg = 1.0f / (1.0f + expf(-r0[e])); const float sc = sg + router_b[gi * 8 + e];
                if (sc > m1) { m2 = m1; i2 = i1; r2 = r1; m1 = sc; i1 = e; r1 = sg; } else if (sc > m2) { m2 = sc; i2 = e; r2 = sg; } }
            float bgs = m1 + m2; int bgi = gi;
#define RT_BFLY(PAT) do { const float og = __int_as_float(__builtin_amdgcn_ds_swizzle(__float_as_int(bgs), PAT)); const int oi = __builtin_amdgcn_ds_swizzle(bgi, PAT); \
                if (og > bgs || (og == bgs && oi < bgi)) { bgs = og; bgi = oi; } } while (0)
            RT_BFLY(0x041F); RT_BFLY(0x081F); RT_BFLY(0x101F);
#undef RT_BFLY
            if (bgi == gi) {
                const int e1 = gi * 8 + i1, e2 = gi * 8 + i2;
                const float inv = 1.0f / (r1 + r2);
                const int p1 = atomicAdd(cnt + e1, 1), p2 = atomicAdd(cnt + e2, 1);
                seg[(size_t)e1 * SEGCAP + p1] = tok * 2; seg[(size_t)e2 * SEGCAP + p2] = tok * 2 + 1;
                gates[tok * 2] = r1 * inv; gates[tok * 2 + 1] = r2 * inv;
            }
        }
        __syncthreads();
    }
}

__device__ __forceinline__ void phase_combine(const Ctx& F, int layer, float* outp, bool write_hb) {
    unsigned char* const ws = opaque_ws(F.ws);
    const bf16_t* H1B = (const bf16_t*)(ws + WS_H1B); const bf16_t* Y = (const bf16_t*)(ws + WS_Y); bf16_t* HB = (bf16_t*)(ws + WS_HB);
    KArgs KA = kargs();
    const float* g = as_global(KA->in[IN_LNG]) + (size_t)(layer * 2 + 1) * D; const float* bta = as_global(KA->in[IN_LNB]) + (size_t)(layer * 2 + 1) * D;
    const int tid = phase_tid(); const int lane = tid & 63, wid = __builtin_amdgcn_readfirstlane(tid >> 6);
    f32x4 gg[8], bb[8];
#pragma unroll
    for (int i = 0; i < 4; ++i) { gg[2 * i] = *(const f32x4*)(g + lane * 8 + 512 * i); gg[2 * i + 1] = *(const f32x4*)(g + lane * 8 + 512 * i + 4);
        bb[2 * i] = *(const f32x4*)(bta + lane * 8 + 512 * i); bb[2 * i + 1] = *(const f32x4*)(bta + lane * 8 + 512 * i + 4); }
    u32x4 ha[4], na[4]; u32x4 yp[4], yq[4], np[4], nq[4];
    int row = F.bid * 8 + wid;
#define CMB_LOAD(A, P, Q, R) do { const bf16_t* hh_ = H1B + (size_t)(R) * D + lane * 8; const bf16_t* y0_ = Y + (size_t)(2 * (R)) * D + lane * 8; \
        _Pragma("unroll") for (int i = 0; i < 4; ++i) { A[i] = *(const u32x4*)(hh_ + 512 * i); \
            P[i] = *(const u32x4*)(y0_ + 512 * i); Q[i] = *(const u32x4*)(y0_ + D + 512 * i); } } while (0)
    if (row < S) CMB_LOAD(ha, yp, yq, row);
    for (; row < S; row += F.G * 8) {
        const int nrow = row + F.G * 8;
        if (nrow < S) CMB_LOAD(na, np, nq, nrow);
        f32x4 v[8];
#pragma unroll
        for (int i = 0; i < 4; ++i) {
            const u32x4 p = yp[i], q = yq[i];
            f32x4 s0, s1;
            s0[0] = __uint_as_float(p.x << 16) + __uint_as_float(q.x << 16); s0[1] = __uint_as_float(p.x & 0xffff0000u) + __uint_as_float(q.x & 0xffff0000u);
            s0[2] = __uint_as_float(p.y << 16) + __uint_as_float(q.y << 16); s0[3] = __uint_as_float(p.y & 0xffff0000u) + __uint_as_float(q.y & 0xffff0000u);
            s1[0] = __uint_as_float(p.z << 16) + __uint_as_float(q.z << 16); s1[1] = __uint_as_float(p.z & 0xffff0000u) + __uint_as_float(q.z & 0xffff0000u);
            s1[2] = __uint_as_float(p.w << 16) + __uint_as_float(q.w << 16); s1[3] = __uint_as_float(p.w & 0xffff0000u) + __uint_as_float(q.w & 0xffff0000u);
            const u32x4 hh = ha[i]; f32x4 h0, h1v;
            h0[0] = __uint_as_float(hh.x << 16); h0[1] = __uint_as_float(hh.x & 0xffff0000u); h0[2] = __uint_as_float(hh.y << 16); h0[3] = __uint_as_float(hh.y & 0xffff0000u);
            h1v[0] = __uint_as_float(hh.z << 16); h1v[1] = __uint_as_float(hh.z & 0xffff0000u); h1v[2] = __uint_as_float(hh.w << 16); h1v[3] = __uint_as_float(hh.w & 0xffff0000u);
            v[2 * i] = h0 * ALPHA + s0; v[2 * i + 1] = h1v * ALPHA + s1; }
        float s = 0.f;
#pragma unroll
        for (int i = 0; i < 8; ++i) s += (v[i][0] + v[i][1]) + (v[i][2] + v[i][3]);
        const float mu = wave_sum(s) * (1.0f / D);
        float q = 0.f;
#pragma unroll
        for (int i = 0; i < 8; ++i) { const f32x4 d = v[i] - mu; q += (d[0] * d[0] + d[1] * d[1]) + (d[2] * d[2] + d[3] * d[3]); }
        const float rstd = __builtin_amdgcn_rsqf(wave_sum(q) * (1.0f / D) + LN_EPS);
        float* orow = outp + (size_t)row * D + lane * 8; bf16_t* hb = HB + (size_t)row * D + lane * 8;
#pragma unroll
        for (int i = 0; i < 4; ++i) {
            const f32x4 y0v = (v[2 * i] - mu) * rstd * gg[2 * i] + bb[2 * i], y1v = (v[2 * i + 1] - mu) * rstd * gg[2 * i + 1] + bb[2 * i + 1];
            if (!write_hb) { *(f32x4*)(orow + 512 * i) = y0v; *(f32x4*)(orow + 512 * i + 4) = y1v; }
            else { u32x4 w; w.x = cvtpk(y0v[0], y0v[1]); w.y = cvtpk(y0v[2], y0v[3]); w.z = cvtpk(y1v[0], y1v[1]); w.w = cvtpk(y1v[2], y1v[3]);
                *(u32x4*)(hb + 512 * i) = w; } }
#pragma unroll
        for (int i = 0; i < 4; ++i) { ha[i] = na[i]; yp[i] = np[i]; yq[i] = nq[i]; }
    }
#undef CMB_LOAD
}

__device__ __forceinline__ void phase_poolprep(const Ctx& F, const bf16_t* H) {
    unsigned char* const ws = opaque_ws(F.ws);
    bf16_t* Dm = (bf16_t*)(ws + WS_AO);
    const int tid = phase_tid(); const int c8 = (tid & 255) * 8, rh = tid >> 8;
    const int half = 1 << (c8 >> 9);
#define PP_LD(A0, A1, R) do { const u32x4 p_ = *(const u32x4*)(H + (size_t)(R) * D + c8); \
        A0[0] = __uint_as_float(p_.x << 16); A0[1] = __uint_as_float(p_.x & 0xffff0000u); A0[2] = __uint_as_float(p_.y << 16); A0[3] = __uint_as_float(p_.y & 0xffff0000u); \
        A1[0] = __uint_as_float(p_.z << 16); A1[1] = __uint_as_float(p_.z & 0xffff0000u); A1[2] = __uint_as_float(p_.w << 16); A1[3] = __uint_as_float(p_.w & 0xffff0000u); } while (0)
    for (int chunk = F.bid; chunk < S / 64; chunk += F.G) {
        const int t0 = chunk * 64 + rh * 32;
        f32x4 s0 = {0.f, 0.f, 0.f, 0.f}, s1 = {0.f, 0.f, 0.f, 0.f};
        for (int r = t0 - half; r < t0 + half; ++r) if (r >= 0 && r < S) { f32x4 a0, a1; PP_LD(a0, a1, r); s0 += a0; s1 += a1; }
#define PP_UP(A0, A1, P) do { const u32x4 p_ = (P); \
        A0[0] = __uint_as_float(p_.x << 16); A0[1] = __uint_as_float(p_.x & 0xffff0000u); A0[2] = __uint_as_float(p_.y << 16); A0[3] = __uint_as_float(p_.y & 0xffff0000u); \
        A1[0] = __uint_as_float(p_.z << 16); A1[1] = __uint_as_float(p_.z & 0xffff0000u); A1[2] = __uint_as_float(p_.w << 16); A1[3] = __uint_as_float(p_.w & 0xffff0000u); } while (0)
#pragma unroll 1
        for (int t4 = t0; t4 < t0 + 32; t4 += 4) {
            u32x4 px[4], pa[4], pd[4];
#pragma unroll
            for (int q = 0; q < 4; ++q) { const int t = t4 + q, ra = t + half, rd = t - half;
                px[q] = *(const u32x4*)(H + (size_t)t * D + c8); pa[q] = *(const u32x4*)(H + (size_t)(ra < S ? ra : S - 1) * D + c8); pd[q] = *(const u32x4*)(H + (size_t)(rd >= 0 ? rd : 0) * D + c8); }
#pragma unroll
            for (int q = 0; q < 4; ++q) { const int t = t4 + q, ra = t + half, rd = t - half;
                const int lo = rd < 0 ? 0 : rd, hiw = ra > S ? S : ra;
                const float inv = 1.0f / (float)(hiw - lo);
                f32x4 x0, x1; PP_UP(x0, x1, px[q]);
                const f32x4 d0 = s0 * inv - x0, d1 = s1 * inv - x1;
                u32x4 w; w.x = cvtpk(d0[0], d0[1]); w.y = cvtpk(d0[2], d0[3]); w.z = cvtpk(d1[0], d1[1]); w.w = cvtpk(d1[2], d1[3]);
                *(u32x4*)(Dm + (size_t)t * D + c8) = w;
                const float wa = ra < S ? 1.f : 0.f, wd = rd >= 0 ? 1.f : 0.f; f32x4 a0, a1, e0, e1;
                PP_UP(a0, a1, pa[q]); PP_UP(e0, e1, pd[q]);
                s0 += a0 * wa - e0 * wd; s1 += a1 * wa - e1 * wd; }
        }
#undef PP_UP
    }
#undef PP_LD
}

__device__ __forceinline__ void moe_tables(const Ctx& F, int layer) {
    unsigned char* const ws = opaque_ws(F.ws);
    LAS int* tab = (LAS int*)(F.lds + LDS_MISC + 64);
    const int* cnt = (const int*)(ws + WS_CTL + CTL_CNT) + layer * 64;
    const int tid = phase_tid();
    if (tid < 64) tab[tid] = cnt[tid];
    __syncthreads();
    if (tid == 0) { int to = 0, ro = 0; for (int e = 0; e < 64; ++e) { tab[64 + e] = to; tab[129 + e] = ro; const int c = tab[e]; to += (c + 255) >> 8; ro += c; } tab[128] = to; tab[193] = ro; }
    __syncthreads();
}

constexpr int N_PHASES = 1 + 8 * DEPTH;
__global__ void __launch_bounds__(NTHREADS, 2) fwd(Args args) {
    extern __shared__ __attribute__((aligned(16))) unsigned char lds_raw[];
    Ctx F;
    F.ws = as_global(args.ws); F.lds = (LAS unsigned char*)lds_raw; F.wv = __builtin_amdgcn_readfirstlane(threadIdx.x >> 6);
    F.G = gridDim.x; F.bid = blockIdx.x;
    const int lo = args.ph_lo, hi = args.ph_hi;
    XcdBarrier bar; bar.bar = (unsigned*)(F.ws + WS_CTL); bar.x = 0; bar.st = (volatile LAS unsigned*)(F.lds + LDS_MISC);
    if (threadIdx.x < 4) ((LAS unsigned*)(F.lds + LDS_MISC))[threadIdx.x] = 0u;
    __syncthreads();
    const bool multi = (hi - lo) > 1;
    if (multi) bar = xcd_barrier_post((unsigned*)(F.ws + WS_CTL), (volatile LAS unsigned*)(F.lds + LDS_MISC));
#define IN(k) (lo <= (k) && (k) < hi)
#define SEAM(k) do { if (IN(k) && IN((k) + 1)) { xcd_barrier(bar); if (PROBE_BAR) xcd_barrier(bar); } } while (0)

    if constexpr (PHMASK & 1) if (IN(0)) { REPEAT(REP_PRO) phase_prologue(F); }
    SEAM(0);
#pragma unroll 1
    for (int layer = 0; layer < DEPTH; ++layer) {
        const int pb = 1 + 8 * layer; const int j = layer >> 1;
        if ((layer & 1) == 0) {
            if constexpr (PHMASK & 2) if (IN(pb + 0)) {     unsigned char* const ws = opaque_ws(F.ws);
                pg8::DenseOrder Sd; Sd.init(ws + WS_HB, ws + WS_WQKV + (size_t)j * 6144 * 2048 * 2, D, D, S, 3 * D, F.G, F.bid);
                pg8::EpiQKV E{(bf16_t*)(ws + WS_Q), (const float*)(ws + WS_ROPE)};
                REPEAT(REP_GEMM) pg8::gemm_phase<pg8::EpiQKV, pg8::DenseOrder, false>(F.lds, F.wv, D, D, D, Sd, E);
            }
            SEAM(pb + 0);
            if constexpr (PHMASK & 4) if (IN(pb + 1)) { REPEAT(REP_ATT) phase_attention(F, j); }
            SEAM(pb + 1);
            if constexpr (PHMASK & 8) if (IN(pb + 2)) {     unsigned char* const ws = opaque_ws(F.ws);
                pg8::DenseOrder Sd; Sd.init(ws + WS_AO, ws + WS_WO + (size_t)j * 2048 * 2048 * 2, D, D, S, D, F.G, F.bid);
                pg8::EpiMix E{(bf16_t*)(ws + WS_Z), nullptr};
                REPEAT(REP_GEMM) pg8::gemm_phase<pg8::EpiMix, pg8::DenseOrder, false>(F.lds, F.wv, D, D, D, Sd, E);
            }
            SEAM(pb + 2);
        } else {
            if constexpr (PHMASK & 16) if (IN(pb + 0)) { REPEAT(REP_TOK) phase_poolprep(F, (const bf16_t*)(opaque_ws(F.ws) + WS_HB)); }
            SEAM(pb + 0);
            if constexpr (PHMASK & 32) if (IN(pb + 1)) {     unsigned char* const ws = opaque_ws(F.ws);
                pg8::PoolOrder Sp{(const char*)(ws + WS_AO), (const char*)(ws + WS_WPOOL + (size_t)j * 4 * 512 * 512 * 2), F.G, F.bid};
                pg8::EpiMix E{(bf16_t*)(ws + WS_Z), as_global(kargs()->in[IN_POOLSC]) + (size_t)j * D};
                REPEAT(REP_GEMM) pg8::gemm_phase<pg8::EpiMix, pg8::PoolOrder, false>(F.lds, F.wv, 512, D, 512, Sp, E);
            }
            SEAM(pb + 1);
        }
        if constexpr (PHMASK & 64) if (IN(pb + 3)) { REPEAT(REP_ROUTE) phase_route(F, layer, rep_ == REP_ROUTE - 1, rep_ == REP_ROUTE - 1 ? 0 : PROBE_RMODE); }
        SEAM(pb + 3);
        if constexpr (PHMASK & 128) if (IN(pb + 4)) {         unsigned char* const ws = opaque_ws(F.ws);
            moe_tables(F, layer);
            pg8::MoeOrder Sm{(const LAS int*)(F.lds + LDS_MISC + 64), (const char*)(ws + WS_H1B), (const char*)(ws + WS_WIN + (size_t)layer * 64 * 1024 * 2048 * 2), (const int*)(ws + WS_SEG), 4, F.G, F.bid, 0, (size_t)1024 * 2048 * 2};
            pg8::EpiMoeIn E{(bf16_t*)(ws + WS_HACT)};
            REPEAT(REP_MOE) pg8::gemm_phase<pg8::EpiMoeIn, pg8::MoeOrder, true>(F.lds, F.wv, D, D, D, Sm, E);
        }
        SEAM(pb + 4);
        if constexpr (PHMASK & 256) if (IN(pb + 5)) {         unsigned char* const ws = opaque_ws(F.ws);
            moe_tables(F, layer);
            pg8::MoeOrder Sm{(const LAS int*)(F.lds + LDS_MISC + 64), (const char*)(ws + WS_HACT), (const char*)(ws + WS_WOUT + (size_t)layer * 64 * 2048 * 512 * 2), (const int*)(ws + WS_SEG), 8, F.G, F.bid, 1, (size_t)2048 * 512 * 2};
            pg8::EpiMoeOut E{(bf16_t*)(ws + WS_Y), (const float*)(ws + WS_GATE)};
            REPEAT(REP_MOE) pg8::gemm_phase<pg8::EpiMoeOut, pg8::MoeOrder, false>(F.lds, F.wv, DFF, DFF, DFF, Sm, E);
        }
        SEAM(pb + 5);
        if constexpr (PHMASK & 512) if (IN(pb + 6)) { REPEAT(REP_TOK) phase_combine(F, layer, as_global(kargs()->out), layer != DEPTH - 1); }
        if (layer + 1 < DEPTH) SEAM(pb + 6);
    }
#undef IN
#undef SEAM
}

extern "C" void kernel_launch(void* const* d_in, const int* in_sizes, int n_in, void* d_out, int out_size, void* d_ws, size_t ws_size, hipStream_t stream) {
    static int grid = 0;
    if (grid == 0) {
        if (n_in != 13 || out_size != S * D || ws_size < WS_END) { fprintf(stderr, "kernel_launch: unexpected shapes (n_in %d out %d ws %zu, need %zu)\n", n_in, out_size, ws_size, (size_t)WS_END); grid = -1; return; }
        int dev = 0, cus = 0, per_cu = 0;
        if (hipGetDevice(&dev) != hipSuccess || hipDeviceGetAttribute(&cus, hipDeviceAttributeMultiprocessorCount, dev) != hipSuccess) { grid = -1; return; }
        if (hipFuncSetAttribute((const void*)fwd, hipFuncAttributeMaxDynamicSharedMemorySize, LDS_BYTES) != hipSuccess) { fprintf(stderr, "kernel_launch: hipFuncSetAttribute failed\n"); grid = -1; return; }
        if (hipOccupancyMaxActiveBlocksPerMultiprocessor(&per_cu, (const void*)fwd, NTHREADS, LDS_BYTES) != hipSuccess || per_cu < 1) { fprintf(stderr, "kernel_launch: occupancy query says %d\n", per_cu); }
        (void)hipGetLastError();
        grid = cus;
    }
    if (grid < 0) return;
    (void)hipMemsetAsync((char*)d_ws + WS_CTL, 0, CTL_ZERO_BYTES, stream);
    Args a{};
    for (int i = 0; i < 13; ++i) a.in[i] = (const float*)d_in[i];
    a.out = (float*)d_out; a.ws = (unsigned char*)d_ws;
#if ONE_LAUNCH
    a.ph_lo = 0; a.ph_hi = N_PHASES;
    hipLaunchKernelGGL(fwd, dim3(grid), dim3(NTHREADS), LDS_BYTES, stream, a);
#else
    for (int p = 0; p < N_PHASES; ++p) {
        const int sub = (p - 1) & 7, layer = (p - 1) >> 3;
        if (p > 0 && (sub == 7 || ((layer & 1) == 1 && sub == 2))) continue;
        a.ph_lo = p; a.ph_hi = p + 1;
        hipLaunchKernelGGL(fwd, dim3(grid), dim3(NTHREADS), LDS_BYTES, stream, a);
    }
#endif
}
```

```cpp
#include <hip/hip_runtime.h>
#include <stdint.h>
#include <stdio.h>

#ifndef PHMASK
#define PHMASK 0xFFFF
#endif
#ifndef PROBE_BAR
#define PROBE_BAR 0
#endif
#ifndef REP_ROUTE
#define REP_ROUTE 1
#endif
#ifndef PROBE_RMODE
#define PROBE_RMODE 0
#endif
#ifndef PROBE_GMFMA
#define PROBE_GMFMA 0
#endif
#ifndef REP_ATT
#define REP_ATT 1
#endif
#ifndef REP_GEMM
#define REP_GEMM 1
#endif
#ifndef REP_MOE
#define REP_MOE 1
#endif
#ifndef REP_PRO
#define REP_PRO 1
#endif
#ifndef REP_TOK
#define REP_TOK 1
#endif
#define REPEAT(n) _Pragma("unroll 1") for (int rep_ = 0; rep_ < (n); ++rep_)
#ifndef ONE_LAUNCH
#define ONE_LAUNCH 1
#endif

#define LAS __attribute__((address_space(3)))
typedef unsigned short bf16_t;
typedef short bf16x8 __attribute__((ext_vector_type(8)));
typedef short s16x4 __attribute__((ext_vector_type(4)));
typedef float f32x2 __attribute__((ext_vector_type(2)));
typedef float f32x4 __attribute__((ext_vector_type(4)));
typedef float f32x16 __attribute__((ext_vector_type(16)));
typedef unsigned u32x2 __attribute__((ext_vector_type(2)));
typedef unsigned u32x4 __attribute__((ext_vector_type(4)));

constexpr int S = 16384, D = 2048, DEPTH = 4, NE = 64, DFF = 512, NH = 8, HD = 128, VD = 256;
constexpr float ALPHA = 1.6817928305074292f;
constexpr float LN_EPS = 1e-5f, RMS_EPS = 1e-5f;
constexpr int NTHREADS = 512;
constexpr int SEGCAP = S;

constexpr size_t AL(size_t x) { return (x + 255) / 256 * 256; }
constexpr size_t WS_CTL   = 0;
constexpr size_t CTL_BAR_WORDS = 3456;
constexpr size_t CTL_CNT  = 16384;
constexpr size_t CTL_ZERO_BYTES = 20480;
constexpr size_t WS_WQKV  = AL(WS_CTL + CTL_ZERO_BYTES);
constexpr size_t WS_WO    = AL(WS_WQKV + (size_t)2 * 6144 * 2048 * 2);
constexpr size_t WS_WPOOL = AL(WS_WO + (size_t)2 * 2048 * 2048 * 2);
constexpr size_t WS_WIN   = AL(WS_WPOOL + (size_t)8 * 512 * 512 * 2);
constexpr size_t WS_WOUT  = AL(WS_WIN + (size_t)256 * 1024 * 2048 * 2);
constexpr size_t WS_ROPE  = AL(WS_WOUT + (size_t)256 * 2048 * 512 * 2);
constexpr size_t WS_H     = AL(WS_ROPE + (size_t)S * 32 * 4);
constexpr size_t WS_HB    = AL(WS_H + (size_t)S * D * 4);
constexpr size_t WS_Q     = AL(WS_HB + (size_t)S * D * 2);
constexpr size_t WS_K     = AL(WS_Q + (size_t)S * D * 2);
constexpr size_t WS_V     = AL(WS_K + (size_t)S * D * 2);
constexpr size_t WS_AO    = AL(WS_V + (size_t)S * D * 2);
constexpr size_t WS_Z     = AL(WS_AO + (size_t)S * D * 2);
constexpr size_t WS_H1    = AL(WS_Z + (size_t)S * D * 4);
constexpr size_t WS_H1B   = AL(WS_H1 + (size_t)S * D * 4);
constexpr size_t WS_HACT  = AL(WS_H1B + (size_t)S * D * 2);
constexpr size_t WS_Y     = AL(WS_HACT + (size_t)(2 * S + 256) * DFF * 2);
constexpr size_t WS_SEG   = AL(WS_Y + (size_t)2 * S * D * 2);
constexpr size_t WS_GATE  = AL(WS_SEG + (size_t)NE * SEGCAP * 4);
constexpr size_t WS_OSCR  = AL(WS_GATE + (size_t)2 * S * 4);
constexpr size_t WS_RT    = AL(WS_OSCR + (size_t)256 * 512 * 128 * 4);
constexpr size_t WS_END   = AL(WS_RT + (size_t)2 * NE * D * 2);
static_assert(WS_V - WS_K == WS_K - WS_Q, "q|k|v spacing");
static_assert(WS_END < 0xFFFFFFFFull, "workspace offsets must fit 32 bits (buffer addressing)");

constexpr int LDS_BYTES = 147456;
constexpr int LDS_MISC  = 131072;

__device__ __forceinline__ unsigned cvtpk(float lo, float hi) { unsigned r; asm volatile("v_cvt_pk_bf16_f32 %0, %1, %2" : "=v"(r) : "v"(lo), "v"(hi)); return r; }
#define SWZ_ADD(v, pat) v += __int_as_float(__builtin_amdgcn_ds_swizzle(__float_as_int(v), pat))
__device__ __forceinline__ float wave_sum(float v) {
    SWZ_ADD(v, 0x041F); SWZ_ADD(v, 0x081F); SWZ_ADD(v, 0x101F); SWZ_ADD(v, 0x201F); SWZ_ADD(v, 0x401F);
    auto rr = __builtin_amdgcn_permlane32_swap(__float_as_uint(v), __float_as_uint(v), false, false);
    return __uint_as_float(rr[0]) + __uint_as_float(rr[1]);
}
template <class T> __device__ __forceinline__ T* as_global(T* p) { return (T*)(__attribute__((address_space(1))) T*)p; }
#define VM_WAIT0() asm volatile("s_waitcnt vmcnt(0)" ::: "memory")
#define LGKM_WAIT0() asm volatile("s_waitcnt lgkmcnt(0)" ::: "memory")
#define SBAR() __builtin_amdgcn_sched_barrier(0)
__device__ __forceinline__ int phase_tid_w(int wv) { unsigned all = ~0u; asm volatile("" : "+s"(all)); return wv * 64 + (int)__builtin_amdgcn_mbcnt_hi(all, __builtin_amdgcn_mbcnt_lo(all, 0u)); }
#define phase_tid() phase_tid_w(F.wv)

#define XB_TMO      128
#define XB_XCNT(j)  (256  + 64 * (j))
#define XB_XSUB(j)  (1280 + 64 * (j))
#define XB_XGEN(j)  (2304 + 64 * (j))
#define XB_TOP      3328
#define XB_TOPGEN   3392
#define XCD_BAR_WORDS 3456
#define XB_SPIN_CAP (1u << 18)

__device__ __forceinline__ unsigned xb_ld(unsigned* p)              { return __hip_atomic_load(p, __ATOMIC_RELAXED, __HIP_MEMORY_SCOPE_AGENT); }
__device__ __forceinline__ unsigned xb_add(unsigned* p, unsigned v) { return __hip_atomic_fetch_add(p, v, __ATOMIC_RELAXED, __HIP_MEMORY_SCOPE_AGENT); }
__device__ __forceinline__ unsigned xb_xcc_id() { return (unsigned)__builtin_amdgcn_s_getreg((3 << 11) | 20) & 0xFu; }
#define XB_SPIN(cond, bar) do { unsigned _sp = 0; while (cond) { __builtin_amdgcn_s_sleep(1); \
    if ((++_sp & 255u) == 0u) { if (xb_ld(&(bar)[XB_TMO])) break; if (_sp > XB_SPIN_CAP) { atomicAdd(&(bar)[XB_TMO], 1u); break; } } } } while (0)

struct XcdBarrier { unsigned* bar; unsigned x; volatile LAS unsigned* st; };

__device__ __forceinline__ XcdBarrier xcd_barrier_post(unsigned* bar, volatile LAS unsigned* st) {
    XcdBarrier b; b.bar = bar; b.x = xb_xcc_id(); b.st = st;
    if (threadIdx.x == 0) (void)xb_add(&bar[XB_XCNT(b.x)], 1u);
    return b;
}
__device__ __forceinline__ void xcd_barrier_complete(unsigned* bar, unsigned x, unsigned& nloc, unsigned& nx) {
    const unsigned G = gridDim.x * gridDim.y * gridDim.z;
    unsigned sum, cnt, mine, sp = 0u;
    for (;;) {
        sum = 0u; cnt = 0u;
#pragma unroll 1
        for (unsigned j = 0; j < 16; ++j) { const unsigned c = xb_ld(&bar[XB_XCNT(j)]); sum += c; cnt += (c > 0u) ? 1u : 0u; }
        mine = xb_ld(&bar[XB_XCNT(x)]);
        if (sum == G) break;
        __builtin_amdgcn_s_sleep(1);
        if ((++sp & 255u) == 0u) { if (xb_ld(&bar[XB_TMO])) break; if (sp > XB_SPIN_CAP) { atomicAdd(&bar[XB_TMO], 1u); break; } }
    }
    nloc = mine > 0u ? mine : 1u; nx = cnt > 0u ? cnt : 1u;
}
__device__ __forceinline__ void xcd_barrier(const XcdBarrier& b) {
    asm volatile("s_waitcnt vmcnt(0)" ::: "memory");
    __syncthreads();
    if (threadIdx.x == 0) {
        unsigned* bar; { size_t z = 0; asm volatile("" : "+s"(z)); bar = as_global(b.bar) + z; }
        __builtin_amdgcn_s_waitcnt(0);
        unsigned nloc = b.st[0], nx = b.st[1];
        if (nloc == 0u) { xcd_barrier_complete(bar, b.x, nloc, nx); b.st[0] = nloc; b.st[1] = nx; }
        const unsigned old = xb_add(&bar[XB_XSUB(b.x)], 1u);
        const unsigned gen = old / nloc;
        if (old + 1u == (gen + 1u) * nloc) {
            __builtin_amdgcn_fence(__ATOMIC_RELEASE, "agent");
            asm volatile("s_waitcnt vmcnt(0)" ::: "memory");
            const unsigned og = xb_add(&bar[XB_TOP], 1u);
            const unsigned tg = og / nx;
            if (og + 1u == (tg + 1u) * nx) xb_add(&bar[XB_TOPGEN], 1u);
            else XB_SPIN(xb_ld(&bar[XB_TOPGEN]) == tg, bar);
            __builtin_amdgcn_fence(__ATOMIC_ACQUIRE, "agent");
            xb_add(&bar[XB_XGEN(b.x)], 1u);
            asm volatile("s_waitcnt vmcnt(0)" ::: "memory");
        } else {
            XB_SPIN(xb_ld(&bar[XB_XGEN(b.x)]) == gen, bar);
            __builtin_amdgcn_fence(__ATOMIC_ACQUIRE, "agent");
            asm volatile("s_waitcnt vmcnt(0)" ::: "memory");
        }
    }
    __syncthreads();
}

namespace pg8 {
constexpr int BM = 256, BK = 64, HALF = 128, HTB = HALF * BK * 2, STAGE_BYTES = 8 * HTB;
__device__ __forceinline__ int lds_byte(int r, int c) { const int st = (r >> 4) * 2 + (c >> 5), rr = r & 15, cc = c & 31, ob = rr * 64 + cc * 2; return st * 1024 + (ob ^ (((ob >> 9) & 1) << 5)); }
__device__ __forceinline__ void stage_rc(int b, int& R, int& C) { const int st = b / 1024, sb = b % 1024, swz = sb ^ (((sb >> 9) & 1) << 5); R = (st >> 1) * 16 + swz / 64; C = (st & 1) * 32 + (swz % 64) / 2; }

struct GUnit { const char* A; const char* B; const int* list; int nvalid; int r0; int c0; int aux; int pad; };

template <class Epi, class Sched, bool GATHER>
__device__ __forceinline__ void gemm_phase(LAS unsigned char* lds, const int wv, const int K, const int lda, const int ldb, const Sched& Sch, const Epi& E) {
    const int tid = phase_tid_w(wv), wid = __builtin_amdgcn_readfirstlane(tid >> 6), lane = tid & 63, wr = wid >> 2, wc = wid & 3, fr = lane & 15, fq = lane >> 4;
    const int nt = K / BK;
    int stR[2], stC[2];
    unsigned voffA[2], voffB[2];
#pragma unroll
    for (int i = 0; i < 2; ++i) { stage_rc(tid * 16 + i * 8192, stR[i], stC[i]);
        voffA[i] = (unsigned)(stR[i] * lda + stC[i]) * 2u; voffB[i] = (unsigned)(stR[i] * ldb + stC[i]) * 2u; }
    unsigned vgc[2][2], vgn[2][2];
    const size_t kstep = (size_t)(BK * 2);
    const size_t hstepA = (size_t)HALF * lda * 2, hstepB = (size_t)HALF * ldb * 2;
    const unsigned ldsw = (unsigned)wid * 1024u;
    const int aoff = lds_byte(wr * 64 + fr, fq * 8), boff = lds_byte(wc * 32 + fr, fq * 8);
#define PG8_SA(b, h) (((b) * 2 + (h)) * HTB)
#define PG8_SB(b, h) ((4 + (b) * 2 + (h)) * HTB)
#define PG8_RAW(bufoff, p0, p1) do { \
        __builtin_amdgcn_global_load_lds((const unsigned*)(p0), (LAS unsigned*)(lds + (bufoff) + ldsw), 16, 0, 0); \
        __builtin_amdgcn_global_load_lds((const unsigned*)(p1), (LAS unsigned*)(lds + (bufoff) + ldsw + 8192), 16, 0, 0); } while (0)
#define PG8_STB(bufoff, gbase) PG8_RAW(bufoff, (gbase) + voffB[0], (gbase) + voffB[1])
#define PG8_STA(bufoff, gbase, h, nx) do { if constexpr (GATHER) { const unsigned _o0 = (nx) ? vgn[h][0] : vgc[h][0], _o1 = (nx) ? vgn[h][1] : vgc[h][1]; PG8_RAW(bufoff, (gbase) + _o0, (gbase) + _o1); } \
        else { PG8_RAW(bufoff, (gbase) + (h) * hstepA + voffA[0], (gbase) + (h) * hstepA + voffA[1]); } } while (0)
#define PG8_LDA(dst, b, h) do { _Pragma("unroll") for (int m = 0; m < 4; ++m) _Pragma("unroll") for (int k = 0; k < 2; ++k) dst[m][k] = *(const LAS bf16x8*)(lds + PG8_SA(b, h) + aoff + m * 2048 + k * 1024); } while (0)
#define PG8_LDB(dst, b, h) do { _Pragma("unroll") for (int n = 0; n < 2; ++n) _Pragma("unroll") for (int k = 0; k < 2; ++k) dst[n][k] = *(const LAS bf16x8*)(lds + PG8_SB(b, h) + boff + n * 2048 + k * 1024); } while (0)
#define PG8_MMA(ai, bj, At, Bt) do { __builtin_amdgcn_s_setprio(1); _Pragma("unroll") for (int m = 0; m < 4; ++m) _Pragma("unroll") for (int n = 0; n < 2; ++n) _Pragma("unroll") for (int k = 0; k < 2; ++k) \
        acc[ai][bj][m][n] = __builtin_amdgcn_mfma_f32_16x16x32_bf16(Bt[n][k], At[m][k], acc[ai][bj][m][n], 0, 0, 0); \
        if (PROBE_GMFMA) { bf16x8 zz = {0, 0, 0, 0, 0, 0, 0, 0}; asm volatile("" : "+v"(zz)); _Pragma("unroll") for (int m = 0; m < 4; ++m) acc[ai][bj][m][0] = __builtin_amdgcn_mfma_f32_16x16x32_bf16(zz, At[m][0], acc[ai][bj][m][0], 0, 0, 0); } \
        __builtin_amdgcn_s_setprio(0); } while (0)
#define PG8_WAIT_V(n) asm volatile("s_waitcnt vmcnt(" #n ")" ::: "memory")
#define PG8_WAIT_L(n) asm volatile("s_waitcnt lgkmcnt(" #n ")" ::: "memory")
#define PG8_BAR __builtin_amdgcn_s_barrier()
#define PG8_SCHED __builtin_amdgcn_sched_barrier(0)
#define PG8_GOFF(dst, u) do { _Pragma("unroll") for (int h = 0; h < 2; ++h) _Pragma("unroll") for (int i = 0; i < 2; ++i) { \
        const int rr = h * HALF + stR[i]; const int sl = (u).list[rr < (u).nvalid ? rr : 0]; dst[h][i] = (unsigned)((sl >> 1) * lda + stC[i]) * 2u; } } while (0)
    GUnit cur, nxt; int ui = 0;
    if (!Sch.next(0, cur)) return;
    f32x4 acc[2][2][4][2];
#pragma unroll
    for (int a = 0; a < 2; ++a)
#pragma unroll
        for (int b = 0; b < 2; ++b)
#pragma unroll
            for (int m = 0; m < 4; ++m)
#pragma unroll
                for (int n = 0; n < 2; ++n) acc[a][b][m][n] = (f32x4){0.f, 0.f, 0.f, 0.f};
    bf16x8 At[4][2], B0[2][2], B1[2][2];
    const char* cA = cur.A; const char* cB = cur.B;
    if constexpr (GATHER) { PG8_GOFF(vgc, cur); }
    PG8_STB(PG8_SB(0, 0), cB); PG8_STA(PG8_SA(0, 0), cA, 0, false); PG8_STB(PG8_SB(0, 1), cB + hstepB); PG8_STA(PG8_SA(0, 1), cA, 1, false);
    if (wr == 1) PG8_BAR;
    PG8_WAIT_V(4); PG8_BAR;
    PG8_STB(PG8_SB(1, 0), cB + kstep); PG8_STA(PG8_SA(1, 0), cA + kstep, 0, false); PG8_STB(PG8_SB(1, 1), cB + hstepB + kstep);
    PG8_WAIT_V(6); PG8_BAR;
    for (;;) {
        const bool has_next = Sch.next(ui + 1, nxt);
        const char* nA = has_next ? nxt.A : cA; const char* nB = has_next ? nxt.B : cB;
        if constexpr (GATHER) {
            if (has_next) { PG8_GOFF(vgn, nxt); }
            else {
#pragma unroll
                for (int h = 0; h < 2; ++h)
#pragma unroll
                    for (int i = 0; i < 2; ++i) vgn[h][i] = vgc[h][i]; }
        }
        for (int t = 0; t < nt; t += 2) {
            const bool last = (t == nt - 2);
            const char* a1 = cA + (size_t)(t + 1) * kstep;
            const char* a2 = last ? nA : cA + (size_t)(t + 2) * kstep; const char* b2 = last ? nB : cB + (size_t)(t + 2) * kstep;
            const char* a3 = a2 + kstep; const char* b3 = b2 + kstep;
            PG8_LDB(B0, 0, 0); PG8_SCHED; PG8_LDA(At, 0, 0); PG8_STA(PG8_SA(1, 1), a1, 1, false);
            PG8_WAIT_L(8); PG8_BAR; PG8_WAIT_L(0); PG8_MMA(0, 0, At, B0); PG8_BAR; PG8_SCHED;
            PG8_LDB(B1, 0, 1); PG8_STB(PG8_SB(0, 0), b2);
            PG8_BAR; PG8_WAIT_L(0); PG8_MMA(0, 1, At, B1); PG8_BAR;
            PG8_LDA(At, 0, 1); PG8_STA(PG8_SA(0, 0), a2, 0, last);
            PG8_BAR; PG8_WAIT_L(0); PG8_MMA(1, 0, At, B0); PG8_BAR; PG8_SCHED;
            PG8_STB(PG8_SB(0, 1), b2 + hstepB);
            PG8_WAIT_V(6); PG8_BAR; PG8_MMA(1, 1, At, B1); PG8_BAR;
            PG8_LDB(B0, 1, 0); PG8_SCHED; PG8_LDA(At, 1, 0); PG8_STA(PG8_SA(0, 1), a2, 1, last);
            PG8_WAIT_L(8); PG8_BAR; PG8_WAIT_L(0); PG8_MMA(0, 0, At, B0); PG8_BAR; PG8_SCHED;
            PG8_LDB(B1, 1, 1); PG8_STB(PG8_SB(1, 0), b3);
            PG8_BAR; PG8_WAIT_L(0); PG8_MMA(0, 1, At, B1); PG8_BAR;
            PG8_LDA(At, 1, 1); PG8_STA(PG8_SA(1, 0), a3, 0, last);
            PG8_BAR; PG8_WAIT_L(0); PG8_MMA(1, 0, At, B0); PG8_BAR; PG8_SCHED;
            PG8_STB(PG8_SB(1, 1), b3 + hstepB);
            PG8_WAIT_V(6); PG8_BAR; PG8_MMA(1, 1, At, B1); PG8_BAR;
        }
        E(acc, cur, wr, wc, fr, fq);
        if (!has_next) break;
#pragma unroll
        for (int a = 0; a < 2; ++a)
#pragma unroll
            for (int b = 0; b < 2; ++b)
#pragma unroll
                for (int m = 0; m < 4; ++m)
#pragma unroll
                    for (int n = 0; n < 2; ++n) acc[a][b][m][n] = (f32x4){0.f, 0.f, 0.f, 0.f};
        cur = nxt; cA = nA; cB = nB; ++ui;
        if constexpr (GATHER) {
#pragma unroll
            for (int h = 0; h < 2; ++h)
#pragma unroll
                for (int i = 0; i < 2; ++i) vgc[h][i] = vgn[h][i]; }
    }
    PG8_WAIT_V(0);
    if (wr == 0) PG8_BAR;
    PG8_BAR;
#undef PG8_SA
#undef PG8_SB
#undef PG8_RAW
#undef PG8_STB
#undef PG8_STA
#undef PG8_LDA
#undef PG8_LDB
#undef PG8_MMA
#undef PG8_WAIT_V
#undef PG8_WAIT_L
#undef PG8_BAR
#undef PG8_SCHED
#undef PG8_GOFF
}

struct DenseOrder {
    const char* A; const char* B; int lda, ldb; int nM, nN, nwg, G, c;
    __device__ __forceinline__ void init(const void* A_, const void* B_, int lda_, int ldb_, int M, int N, int G_, int c_) { A = (const char*)A_; B = (const char*)B_; lda = lda_; ldb = ldb_; nM = M / BM; nN = N / BM; nwg = nM * nN; G = G_; c = c_; }
    __device__ __forceinline__ bool next(int i, GUnit& u) const {
        const long L = (long)i * G + c; if (L >= nwg) return false;
        int wgid = (int)L; { const int q = nwg / 8, r = nwg % 8, xcd = wgid % 8, off = wgid / 8; wgid = (xcd < r ? xcd * (q + 1) : r * (q + 1) + (xcd - r) * q) + off; }
        const int nig = 8 * nN, gid = wgid / nig, fm = gid * 8, gsz = (nM - fm) < 8 ? (nM - fm) : 8;
        const int pm = fm + ((wgid % nig) % gsz), pn = (wgid % nig) / gsz;
        u.A = A + (size_t)pm * BM * lda * 2; u.B = B + (size_t)pn * BM * ldb * 2; u.list = nullptr; u.nvalid = 256; u.r0 = pm * BM; u.c0 = pn * BM; u.aux = 0; u.pad = 0; return true;
    }
};
struct PoolOrder {
    const char* A; const char* B; int G, c;
    __device__ __forceinline__ bool next(int i, GUnit& u) const {
        const int L = i * G + c; if (L >= 512) return false;
        const int g = L >> 7, pm = (L & 127) >> 1, pn = L & 1;
        u.A = A + ((size_t)pm * BM * D + (size_t)g * 512) * 2; u.B = B + ((size_t)g * 512 * 512 + (size_t)pn * BM * 512) * 2;
        u.list = nullptr; u.nvalid = 256; u.r0 = pm * BM; u.c0 = g * 512 + pn * BM; u.aux = g; u.pad = 0; return true;
    }
};
struct MoeOrder {
    const LAS int* tab; const char* A; const char* B; const int* seg; int nN, G, c, mode; size_t bstride;
    __device__ __forceinline__ bool next(int i, GUnit& u) const {
        const int cx = (G % 8 == 0) ? (c % 8) * (G / 8) + c / 8 : c;
        const int L = i * G + cx; const int ntile = tab[64 + 64];
        if (L >= ntile * nN) return false;
        const int rtg = L / nN, pn = L % nN;
        int e = 0;
#pragma unroll 1
        for (int j = 32; j >= 1; j >>= 1) if (tab[64 + e + j] <= rtg) e += j;
        const int rt = rtg - tab[64 + e], cnt = tab[e], roff = tab[129 + e];
        u.nvalid = (cnt - rt * BM) < BM ? (cnt - rt * BM) : BM;
        u.list = seg + (size_t)e * SEGCAP + rt * BM;
        u.r0 = roff + rt * BM; u.c0 = pn * BM; u.aux = e; u.pad = 0;
        u.B = B + (size_t)e * bstride + (size_t)pn * BM * (mode == 0 ? D : DFF) * 2;
        u.A = mode == 0 ? A : A + (size_t)(roff + rt * BM) * DFF * 2;
        return true;
    }
};

struct EpiQKV {
    bf16_t* Q; const float* rope;
    __device__ __forceinline__ void operator()(const f32x4 (&acc)[2][2][4][2], const GUnit& u, int wr, int wc, int fr, int fq) const {
        const int region = u.c0 >> 11; bf16_t* base = Q + (size_t)region * ((WS_K - WS_Q) / 2);
        const int col0 = (u.c0 & 2047) + wc * 32 + 4 * fq; const bool rot = (region < 2) && (wc == 0);
        const float qs = region == 0 ? 0.12751743074602334f : 1.0f;
        f32x4 cs[2][4], sn[2][4];
#pragma unroll
        for (int ai = 0; ai < 2; ++ai)
#pragma unroll
            for (int m = 0; m < 4; ++m) { cs[ai][m] = (f32x4){1.f, 1.f, 1.f, 1.f}; sn[ai][m] = (f32x4){0.f, 0.f, 0.f, 0.f}; }
        if (rot) {
#pragma unroll
            for (int ai = 0; ai < 2; ++ai)
#pragma unroll
                for (int m = 0; m < 4; ++m) { const int row = u.r0 + ai * HALF + wr * 64 + m * 16 + fr;
                    cs[ai][m] = *(const f32x4*)(rope + (size_t)row * 32 + 4 * fq); sn[ai][m] = *(const f32x4*)(rope + (size_t)row * 32 + 16 + 4 * fq); }
        }
#pragma unroll
        for (int ai = 0; ai < 2; ++ai)
#pragma unroll
            for (int m = 0; m < 4; ++m) {
                const int row = u.r0 + ai * HALF + wr * 64 + m * 16 + fr;
                bf16_t* rowp = base + (size_t)row * D + col0;
#pragma unroll
                for (int bj = 0; bj < 2; ++bj) {
                    const f32x4 v0 = acc[ai][bj][m][0], v1 = acc[ai][bj][m][1];
                    const f32x4 o0 = (v0 * cs[ai][m] - v1 * sn[ai][m]) * qs, o1 = (v1 * cs[ai][m] + v0 * sn[ai][m]) * qs;
                    u32x2 w0, w1; w0.x = cvtpk(o0[0], o0[1]); w0.y = cvtpk(o0[2], o0[3]); w1.x = cvtpk(o1[0], o1[1]); w1.y = cvtpk(o1[2], o1[3]);
                    *(u32x2*)(rowp + bj * HALF) = w0; *(u32x2*)(rowp + bj * HALF + 16) = w1; }
            }
    }
};
struct EpiMix {
    bf16_t* M; const float* scale;
    __device__ __forceinline__ void operator()(const f32x4 (&acc)[2][2][4][2], const GUnit& u, int wr, int wc, int fr, int fq) const {
        const int col0 = u.c0 + wc * 32 + 4 * fq;
        f32x4 sc[2][2];
#pragma unroll
        for (int bj = 0; bj < 2; ++bj)
#pragma unroll
            for (int n = 0; n < 2; ++n) sc[bj][n] = scale ? *(const f32x4*)(scale + col0 + bj * HALF + n * 16) : (f32x4){1.f, 1.f, 1.f, 1.f};
#pragma unroll
        for (int ai = 0; ai < 2; ++ai)
#pragma unroll
            for (int m = 0; m < 4; ++m) { bf16_t* rowp = M + (size_t)(u.r0 + ai * HALF + wr * 64 + m * 16 + fr) * D + col0;
#pragma unroll
                for (int bj = 0; bj < 2; ++bj)
#pragma unroll
                    for (int n = 0; n < 2; ++n) { const f32x4 o = acc[ai][bj][m][n] * sc[bj][n]; u32x2 w; w.x = cvtpk(o[0], o[1]); w.y = cvtpk(o[2], o[3]); *(u32x2*)(rowp + bj * HALF + n * 16) = w; } }
    }
};
struct EpiMoeIn {
    bf16_t* H;
    __device__ __forceinline__ void operator()(const f32x4 (&acc)[2][2][4][2], const GUnit& u, int wr, int wc, int fr, int fq) const {
        const int col0 = (u.c0 >> 1) + wc * 32 + 4 * fq;
#pragma unroll
        for (int ai = 0; ai < 2; ++ai)
#pragma unroll
            for (int m = 0; m < 4; ++m) {
                const int r = ai * HALF + wr * 64 + m * 16 + fr;
                if (r < u.nvalid) {
                    bf16_t* rowp = H + (size_t)(u.r0 + r) * DFF + col0;
#pragma unroll
                    for (int n = 0; n < 2; ++n) { const f32x4 g = acc[ai][0][m][n], up = acc[ai][1][m][n]; f32x4 o;
#pragma unroll
                        for (int j = 0; j < 4; ++j) o[j] = g[j] * __builtin_amdgcn_rcpf(1.0f + __builtin_amdgcn_exp2f(-1.4426950408889634f * g[j])) * up[j];
                        u32x2 w; w.x = cvtpk(o[0], o[1]); w.y = cvtpk(o[2], o[3]); *(u32x2*)(rowp + n * 16) = w; }
                }
            }
    }
};
struct EpiMoeOut {
    bf16_t* Y; const float* gates;
    __device__ __forceinline__ void operator()(const f32x4 (&acc)[2][2][4][2], const GUnit& u, int wr, int wc, int fr, int fq) const {
        const int col0 = u.c0 + wc * 32 + 4 * fq;
        int slot[2][4]; float g[2][4];
#pragma unroll
        for (int ai = 0; ai < 2; ++ai)
#pragma unroll
            for (int m = 0; m < 4; ++m) { const int r = ai * HALF + wr * 64 + m * 16 + fr; slot[ai][m] = u.list[r < u.nvalid ? r : 0]; }
#pragma unroll
        for (int ai = 0; ai < 2; ++ai)
#pragma unroll
            for (int m = 0; m < 4; ++m) g[ai][m] = gates[slot[ai][m]];
#pragma unroll
        for (int ai = 0; ai < 2; ++ai)
#pragma unroll
            for (int m = 0; m < 4; ++m) {
                const int r = ai * HALF + wr * 64 + m * 16 + fr;
                if (r < u.nvalid) {
                    bf16_t* rowp = Y + (size_t)slot[ai][m] * D + col0;
#pragma unroll
                    for (int bj = 0; bj < 2; ++bj)
#pragma unroll
                        for (int n = 0; n < 2; ++n) { const f32x4 o = acc[ai][bj][m][n] * g[ai][m]; u32x2 w; w.x = cvtpk(o[0], o[1]); w.y = cvtpk(o[2], o[3]); *(u32x2*)(rowp + bj * HALF + n * 16) = w; }
                }
            }
    }
};
}

struct Args { const float* in[13]; float* out; unsigned char* ws; int ph_lo, ph_hi; };
struct Ctx { unsigned char* ws; LAS unsigned char* lds; int G, bid, wv; };
typedef const __attribute__((address_space(4))) Args* KArgs;
__device__ __forceinline__ KArgs kargs() { KArgs p = (KArgs)__builtin_amdgcn_kernarg_segment_ptr(); asm volatile("" : "+s"(p)); return p; }
__device__ __forceinline__ unsigned char* opaque_ws(unsigned char* p) { size_t z = 0; asm volatile("" : "+s"(z)); return as_global(p) + z; }
enum { IN_X = 0, IN_WQKV, IN_LAMBDA, IN_SUBLN, IN_WO, IN_POOLW, IN_POOLSC, IN_ROUTERW, IN_ROUTERB, IN_MOEIN, IN_MOEOUT, IN_LNG, IN_LNB };

constexpr int P0_QKV = 2 * 16 * 48, P0_WO = 2 * 16 * 16, P0_POOL = 8 * 4 * 4, P0_MIN = 256 * 16 * 8, P0_MOUT = 256 * 4 * 16;
__device__ __forceinline__ void p0_decode(int ur, unsigned char* ws, KArgs KA, const float*& src, bf16_t*& dst, int& ldn, int& K) {
    int u = (P0_QKV + P0_WO + P0_POOL + P0_MIN + P0_MOUT - 1) - ur;
    int mat, kt, ntile, n0s, n0d;
    if (u < P0_QKV) { mat = u / 768; const int r = u % 768; kt = r / 48; ntile = r % 48; ldn = 6144; K = 2048; n0s = n0d = ntile * 128;
        src = as_global(KA->in[IN_WQKV]) + (size_t)mat * 2048 * 6144; dst = (bf16_t*)(ws + WS_WQKV) + (size_t)mat * 6144 * 2048; }
    else if ((u -= P0_QKV) < P0_WO) { mat = u / 256; const int r = u % 256; kt = r / 16; ntile = r % 16; ldn = 2048; K = 2048; n0s = n0d = ntile * 128;
        src = as_global(KA->in[IN_WO]) + (size_t)mat * 2048 * 2048; dst = (bf16_t*)(ws + WS_WO) + (size_t)mat * 2048 * 2048; }
    else if ((u -= P0_WO) < P0_POOL) { mat = u / 16; const int r = u % 16; kt = r / 4; ntile = r % 4; ldn = 512; K = 512; n0s = n0d = ntile * 128;
        src = as_global(KA->in[IN_POOLW]) + (size_t)mat * 512 * 512; dst = (bf16_t*)(ws + WS_WPOOL) + (size_t)mat * 512 * 512; }
    else if ((u -= P0_POOL) < P0_MIN) { mat = u / 128; const int r = u % 128; kt = r / 8; ntile = r % 8; ldn = 1024; K = 2048; n0s = ntile * 128;
        { const int bj = n0s >> 9, pn = (n0s & 511) >> 7; n0d = 256 * pn + 128 * bj; }
        src = as_global(KA->in[IN_MOEIN]) + (size_t)mat * 2048 * 1024; dst = (bf16_t*)(ws + WS_WIN) + (size_t)mat * 1024 * 2048; }
    else { u -= P0_MIN; mat = u / 64; const int r = u % 64; kt = r / 16; ntile = r % 16; ldn = 2048; K = 512; n0s = n0d = ntile * 128;
        src = as_global(KA->in[IN_MOEOUT]) + (size_t)mat * 512 * 2048; dst = (bf16_t*)(ws + WS_WOUT) + (size_t)mat * 2048 * 512; }
    src += (size_t)kt * 128 * ldn + n0s; dst += (size_t)n0d * K + kt * 128;
}
constexpr int P0_UNITS = P0_QKV + P0_WO + P0_POOL + P0_MIN + P0_MOUT;
__device__ __forceinline__ void sincos_d(double a, double& s, double& c) {
    const double k = rint(a * 0.63661977236758134308);
    double r = fma(-k, 1.57079632679489655800e+00, a); r = fma(-k, 6.12323399573676603587e-17, r);
    const double r2 = r * r;
    double sp = r2 * (1.0 / 6227020800.0) - 1.0 / 39916800.0; sp = sp * r2 + 1.0 / 362880.0; sp = sp * r2 - 1.0 / 5040.0; sp = sp * r2 + 1.0 / 120.0; sp = sp * r2 - 1.0 / 6.0; sp = sp * r2 * r + r;
    double cp = r2 * (-1.0 / 87178291200.0) + 1.0 / 479001600.0; cp = cp * r2 - 1.0 / 3628800.0; cp = cp * r2 + 1.0 / 40320.0; cp = cp * r2 - 1.0 / 720.0; cp = cp * r2 + 1.0 / 24.0; cp = cp * r2 - 0.5; cp = cp * r2 + 1.0;
    const int q = ((int)k) & 3;
    s = (q == 0) ? sp : (q == 1) ? cp : (q == 2) ? -sp : -cp;
    c = (q == 0) ? cp : (q == 1) ? -sp : (q == 2) ? -cp : sp;
}
__device__ __forceinline__ void p0_convert(const Ctx& F, unsigned char* ws, KArgs KA, int tid, int u_begin, int u_end) {
    LAS unsigned short* T = (LAS unsigned short*)F.lds;
    constexpr int TP = 130;
    const int kr = tid >> 5, nc = (tid & 31) * 4;
    const int on = tid >> 2, ok = (tid & 3) * 32;
    int u = u_begin + F.bid;
    f32x4 v[8];
    const float* src; bf16_t* dst; int ldn, K;
    if (u < u_end) { p0_decode(u, ws, KA, src, dst, ldn, K);
#pragma unroll
        for (int i = 0; i < 8; ++i) v[i] = *(const f32x4*)(src + (size_t)(kr + 16 * i) * ldn + nc); }
    while (u < u_end) {
#pragma unroll
        for (int i = 0; i < 8; ++i) { const int k = kr + 16 * i;
            const unsigned p0 = cvtpk(v[i][0], v[i][1]), p1 = cvtpk(v[i][2], v[i][3]);
            T[(nc + 0) * TP + k] = (unsigned short)(p0 & 0xffff); T[(nc + 1) * TP + k] = (unsigned short)(p0 >> 16);
            T[(nc + 2) * TP + k] = (unsigned short)(p1 & 0xffff); T[(nc + 3) * TP + k] = (unsigned short)(p1 >> 16); }
        bf16_t* cdst = dst; const int cK = K;
        const int un = u + F.G;
        if (un < u_end) { p0_decode(un, ws, KA, src, dst, ldn, K);
#pragma unroll
            for (int i = 0; i < 8; ++i) v[i] = *(const f32x4*)(src + (size_t)(kr + 16 * i) * ldn + nc); }
        __syncthreads();
        { unsigned w[16];
#pragma unroll
          for (int j = 0; j < 16; ++j) w[j] = *(const LAS unsigned*)(T + on * TP + ok + 2 * j);
#pragma unroll
          for (int q = 0; q < 4; ++q) { u32x4 ww = {w[4 * q], w[4 * q + 1], w[4 * q + 2], w[4 * q + 3]}; *(u32x4*)(cdst + (size_t)on * cK + ok + 8 * q) = ww; } }
        __syncthreads();
        u = un;
    }
}
__device__ __forceinline__ void phase_prologue(const Ctx& F) {
    unsigned char* const ws = opaque_ws(F.ws);
    const int tid = phase_tid(); KArgs KA = kargs();
    constexpr int N_MOE_UNITS = P0_MIN + P0_MOUT;
    if (F.G != 256) p0_convert(F, ws, KA, tid, 0, N_MOE_UNITS);
    for (int e = F.bid * NTHREADS + tid; e < S * 16; e += F.G * NTHREADS) {
        const int pos = e >> 4, i = e & 15;
        const float invf = (float)exp2(-(double)i * (18.931568569324174087 / 16.0));
        const float ang = (float)pos * invf;
        double s, c; sincos_d((double)ang, s, c);
        float* rp = (float*)(ws + WS_ROPE) + (size_t)pos * 32; rp[i] = (float)c; rp[16 + i] = (float)s;
    }
    { const float* x = as_global(KA->in[IN_X]); bf16_t* hb = (bf16_t*)(ws + WS_HB);
      for (size_t i = (size_t)F.bid * NTHREADS + tid; i < (size_t)S * D / 8; i += (size_t)F.G * NTHREADS) {
          const f32x4 a = *(const f32x4*)(x + i * 8), b = *(const f32x4*)(x + i * 8 + 4);
          u32x4 w; w.x = cvtpk(a[0], a[1]); w.y = cvtpk(a[2], a[3]); w.z = cvtpk(b[0], b[1]); w.w = cvtpk(b[2], b[3]);
          *(u32x4*)(hb + i * 8) = w; } }
    { const float* rw = as_global(KA->in[IN_ROUTERW]); bf16_t* rth = (bf16_t*)(ws + WS_RT); bf16_t* rtl = rth + NE * D;
      for (int i = F.bid * NTHREADS + tid; i < D * NE; i += F.G * NTHREADS) { const int k = i >> 6, e = i & 63; const float x = rw[i];
          const unsigned h = cvtpk(x, 0.f) & 0xffffu; const float r = x - __uint_as_float(h << 16); const unsigned l = cvtpk(r, 0.f) & 0xffffu;
          rth[e * D + k] = (bf16_t)h; rtl[e * D + k] = (bf16_t)l; } }
    __syncthreads();
    p0_convert(F, ws, KA, tid, N_MOE_UNITS, P0_UNITS);
}

namespace att {
constexpr int KVBLK = 64;
constexpr int SHM_K = KVBLK * HD * 2  , SHM_V = KVBLK * VD * 2  ;
constexpr int OFF_K = 0, OFF_V = 2 * SHM_K;
#define KSWZ(row, colB) ((row) * 256 + ((colB) ^ (((row) & 15) << 4)))
__device__ __forceinline__ int crow(int r, int hi) { return (r & 3) + 8 * (r >> 2) + 4 * hi; }
__device__ __forceinline__ int v_st(int k, int c) { const int kk = (k & ~0xC) | ((k & 4) << 1) | ((k & 8) >> 1); return ((kk >> 3) * 8 + (c >> 5)) * 512 + ((kk & 7) * 32 + (c & 31)) * 2; }
__device__ __forceinline__ int v_rd_base(int lane) { return ((lane & 3) << 3) | (((lane >> 2) & 3) << 6) | (((lane >> 4) & 1) << 5) | (((lane >> 5) & 1) << 8); }
constexpr int v_rd_off(int d0, int ks, int half) { return d0 * 512 + ks * 8192 + half * 4096; }
template <int OFF> __device__ __forceinline__ s16x4 tr_read(int vb) {
    s16x4 r; asm volatile("ds_read_b64_tr_b16 %0, %1 offset:%2" : "=&v"(r) : "v"(vb), "i"(OFF) : "memory"); return r;
}
template <int OFF> __device__ __forceinline__ bf16x8 lds_read128(int a) {
    bf16x8 r; asm volatile("ds_read_b128 %0, %1 offset:%2" : "=&v"(r) : "v"(a), "i"(OFF) : "memory"); return r;
}
template <int OFF> __device__ __forceinline__ void lds_write128(int a, u32x4 v) {
    asm volatile("ds_write_b128 %0, %1 offset:%2" :: "v"(a), "v"(v), "i"(OFF) : "memory");
}
#define PKV(L, H) (bf16x8){L[0], L[1], L[2], L[3], H[0], H[1], H[2], H[3]}
#define WAIT_LGKM(n) do { asm volatile("s_waitcnt lgkmcnt(" #n ")" ::: "memory"); SBAR(); } while (0)
#define PV_RD(R, D0, H) do { R##0 = tr_read<v_rd_off(D0, 2 * (H), 0)>(vb); R##1 = tr_read<v_rd_off(D0, 2 * (H), 1)>(vb); R##2 = tr_read<v_rd_off(D0, 2 * (H) + 1, 0)>(vb); R##3 = tr_read<v_rd_off(D0, 2 * (H) + 1, 1)>(vb); } while (0)
#define PV_MM(R, D0, PA, PB) do { o[D0] = __builtin_amdgcn_mfma_f32_32x32x16_bf16(PA, PKV(R##0, R##1), o[D0], 0, 0, 0); o[D0] = __builtin_amdgcn_mfma_f32_32x32x16_bf16(PB, PKV(R##2, R##3), o[D0], 0, 0, 0); SBAR(); } while (0)
template <int D_LO> __device__ __forceinline__ void pv_quad(f32x16 (&o)[8], int vb, const bf16x8& pa0, const bf16x8& pa1, const bf16x8& pa2, const bf16x8& pa3) {
    s16x4 A0, A1, A2, A3, B0, B1, B2, B3;
    PV_RD(A, D_LO + 0, 0); PV_RD(B, D_LO + 0, 1);
    WAIT_LGKM(4); PV_MM(A, D_LO + 0, pa0, pa1); PV_RD(A, D_LO + 1, 0);
    WAIT_LGKM(4); PV_MM(B, D_LO + 0, pa2, pa3); PV_RD(B, D_LO + 1, 1);
    WAIT_LGKM(4); PV_MM(A, D_LO + 1, pa0, pa1); PV_RD(A, D_LO + 2, 0);
    WAIT_LGKM(4); PV_MM(B, D_LO + 1, pa2, pa3); PV_RD(B, D_LO + 2, 1);
    WAIT_LGKM(4); PV_MM(A, D_LO + 2, pa0, pa1); PV_RD(A, D_LO + 3, 0);
    WAIT_LGKM(4); PV_MM(B, D_LO + 2, pa2, pa3); PV_RD(B, D_LO + 3, 1);
    WAIT_LGKM(4); PV_MM(A, D_LO + 3, pa0, pa1);
    WAIT_LGKM(0); PV_MM(B, D_LO + 3, pa2, pa3);
}
#define QK_RD(R, KB, DH) do { R##0 = lds_read128<(DH) * 128>(KB); R##1 = lds_read128<(DH) * 128 + 8192>(KB); } while (0)
#define QK_MM(R, Q) do { p0 = __builtin_amdgcn_mfma_f32_32x32x16_bf16(R##0, Q, p0, 0, 0, 0); p1 = __builtin_amdgcn_mfma_f32_32x32x16_bf16(R##1, Q, p1, 0, 0, 0); SBAR(); } while (0)
__device__ __forceinline__ void qk_tile(f32x16& p0, f32x16& p1, int k0, int k1, int k2, int k3, const bf16x8 (&qr)[8]) {
    bf16x8 A0, A1, B0, B1;
    QK_RD(A, k0, 0); QK_RD(B, k1, 0);
    WAIT_LGKM(2); QK_MM(A, qr[0]); QK_RD(A, k2, 0);
    WAIT_LGKM(2); QK_MM(B, qr[1]); QK_RD(B, k3, 0);
    WAIT_LGKM(2); QK_MM(A, qr[2]); QK_RD(A, k0 ^ 128, 0);
    WAIT_LGKM(2); QK_MM(B, qr[3]); QK_RD(B, k1 ^ 128, 0);
    WAIT_LGKM(2); QK_MM(A, qr[4]); QK_RD(A, k2 ^ 128, 0);
    WAIT_LGKM(2); QK_MM(B, qr[5]); QK_RD(B, k3 ^ 128, 0);
    WAIT_LGKM(2); QK_MM(A, qr[6]);
    WAIT_LGKM(0); QK_MM(B, qr[7]);
}
constexpr float THR_UP = 11.5f, THR_DN = 40.f;
__device__ __forceinline__ void softmax_tile(f32x16& p0, f32x16& p1, float& m_reg, float& l_reg, bool& mz, float& alpha, bf16x8& pa0, bf16x8& pa1, bf16x8& pa2, bf16x8& pa3) {
    float pmax = p0[0];
#pragma unroll
    for (int r = 1; r < 16; ++r) pmax = fmaxf(pmax, p0[r]);
#pragma unroll
    for (int r = 0; r < 16; ++r) pmax = fmaxf(pmax, p1[r]);
    { auto rr = __builtin_amdgcn_permlane32_swap(__float_as_uint(pmax), __float_as_uint(pmax), false, false);
      pmax = fmaxf(__uint_as_float(rr[0]), __uint_as_float(rr[1])); }
    const bool ok = (pmax <= THR_UP) && (pmax >= -THR_DN);
    alpha = 1.f;
    if (__builtin_expect(!__all(ok), 0)) {
        const float dlt = ok ? 0.f : fmaxf(pmax, -120.f);
        alpha = __builtin_amdgcn_exp2f(-dlt); m_reg += dlt; mz = __all(m_reg == 0.f);
#pragma unroll
        for (int r = 0; r < 16; ++r) { p0[r] -= dlt; p1[r] -= dlt; }
    }
#pragma unroll
    for (int r = 0; r < 16; ++r) { p0[r] = __builtin_amdgcn_exp2f(p0[r]); p1[r] = __builtin_amdgcn_exp2f(p1[r]); }
    float ps = 0;
#pragma unroll
    for (int r = 0; r < 16; ++r) ps += p0[r];
#pragma unroll
    for (int r = 0; r < 16; ++r) ps += p1[r];
    { auto rr = __builtin_amdgcn_permlane32_swap(__float_as_uint(ps), __float_as_uint(ps), false, false);
      ps = __uint_as_float(rr[0]) + __uint_as_float(rr[1]); }
    l_reg = l_reg * alpha + ps;
#define PK4(P, BASE, OUT) do { unsigned a0 = cvtpk(P[BASE + 0], P[BASE + 1]), a1 = cvtpk(P[BASE + 2], P[BASE + 3]);   \
    unsigned b0 = cvtpk(P[BASE + 4], P[BASE + 5]), b1 = cvtpk(P[BASE + 6], P[BASE + 7]);                              \
    auto r0 = __builtin_amdgcn_permlane32_swap(a0, b0, false, false); auto r1 = __builtin_amdgcn_permlane32_swap(a1, b1, false, false); \
    u32x4 w = {r0[0], r1[0], r0[1], r1[1]}; OUT = *reinterpret_cast<bf16x8*>(&w); } while (0)
    PK4(p0, 0, pa0); PK4(p0, 8, pa1); PK4(p1, 0, pa2); PK4(p1, 8, pa3);
#undef PK4
}

template <bool BG> __device__ __forceinline__ void attn_unit(const Ctx& F, const bf16_t* Qg, const bf16_t* Kg, const bf16_t* Vg, bf16_t* AO, const float* subg, float lam, float outscale, int h, int qb, int bgpass0) {
    unsigned char* const ws = opaque_ws(F.ws);
    const int ldsb = (int)(uintptr_t)F.lds;
    const int tid = phase_tid(), wid = __builtin_amdgcn_readfirstlane(tid >> 6), lane = tid & 63, r32 = lane & 31, hi = lane >> 5;
    const int grp = wid >> 2;
    LAS float* wsf = (LAS float*)(F.lds + LDS_MISC + 1024) + wid * 64;
    LAS float* li_l = wsf; LAS float* al_l = wsf + 32;
    constexpr int NT = S / KVBLK;
    const int ta = tid & 255;
    const __amdgpu_buffer_rsrc_t rW = __builtin_amdgcn_make_buffer_rsrc((void*)ws, 0, 0xFFFFFFFFu, 0x00020000);
    const int wK = ldsb + OFF_K + KSWZ(ta >> 4, (ta & 15) * 16);
    const int wV = ldsb + OFF_V + v_st(ta >> 5, (ta & 31) * 8);
    const int vrd = ldsb + OFF_V + v_rd_base(lane);
    const int x15 = (r32 & 15) << 4;
    for (int comp = 0; comp < 2; ++comp) {
        const int voQ = ((qb * 256 + wid * 32 + r32) * D + h * 256 + comp * 128 + hi * 8) * 2;
        const int voK = (((ta >> 4) * D) + h * 256 + comp * 128 + (ta & 15) * 8) * 2;
        const int voV = (((ta >> 5) * D) + h * 256 + (ta & 31) * 8) * 2;
        bf16x8 qr[8];
#pragma unroll
        for (int d0 = 0; d0 < 8; ++d0) { const u32x4 qv = __builtin_amdgcn_raw_buffer_load_b128(rW, voQ, (int)(unsigned)WS_Q + d0 * 32, 0); qr[d0] = *reinterpret_cast<const bf16x8*>(&qv); }
        f32x16 o[8];
#pragma unroll
        for (int d = 0; d < 8; ++d) o[d] = f32x16{};
        float m_reg = 0.f, l_reg = 0.f; bool mz = true;
        const int bgpass = bgpass0 + comp;
        const int bgm = !BG ? 0 : bgpass < 2 ? 1 : bgpass == 2 ? 2 : 0;
        const int bgN = bgm == 1 ? 1024 : 2048, bgK = bgm == 1 ? 2048 : 512;
        const float* bgsrc = as_global(kargs()->in[IN_MOEIN]); unsigned bgdst = 0;
        LAS unsigned char* const bgl = F.lds + 98304 + wid * 2048;
        if (bgm == 1) { const int n0 = (F.bid & 31) * 32, nd = 256 * ((n0 & 511) >> 7) + 128 * (n0 >> 9) + (n0 & 127);
            bgsrc = as_global(kargs()->in[IN_MOEIN]) + (size_t)bgpass * 256 * 1048576 + (F.bid >> 5) * 131072 + wid * 16384 + n0;
            bgdst = (unsigned)WS_WIN + (unsigned)bgpass * (128u * 2097152u * 2u) + (unsigned)(nd * 2048 + (F.bid >> 5) * 128 + wid * 16) * 2u; }
        else if (bgm == 2) { const int n0 = (F.bid & 63) * 32;
            bgsrc = as_global(kargs()->in[IN_MOEOUT]) + (F.bid >> 6) * (128 * 2048) + wid * (16 * 2048) + n0;
            bgdst = (unsigned)WS_WOUT + (unsigned)(n0 * 512 + (F.bid >> 6) * 128 + wid * 16) * 2u; }
        const unsigned long long bgp_ = (unsigned long long)(uintptr_t)bgsrc;
        const unsigned bgp0 = __builtin_amdgcn_readfirstlane((unsigned)bgp_), bgp1 = __builtin_amdgcn_readfirstlane((unsigned)(bgp_ >> 32)), bgnr = __builtin_amdgcn_readfirstlane(bgm ? 0xFFFFFFFFu : 0u);
#define BG_RSRC() __builtin_amdgcn_make_buffer_rsrc((void*)(uintptr_t)(((unsigned long long)(unsigned)__builtin_amdgcn_readfirstlane(bgp1) << 32) | (unsigned long long)(unsigned)__builtin_amdgcn_readfirstlane(bgp0)), 0, __builtin_amdgcn_readfirstlane(bgnr), 0x00020000)
#define BG_ISSUE(t) do { if constexpr (BG) { int lq = lane; asm volatile("" : "+v"(lq)); int lb_ = (int)(uintptr_t)bgl; asm volatile("" : "+s"(lb_)); \
            const int vo_ = ((lq >> 3) * bgN + 4 * (lq & 7)) * 4; const int so_ = (t) * 4194304; \
            const __amdgpu_buffer_rsrc_t rB_ = BG_RSRC(); \
            __builtin_amdgcn_raw_ptr_buffer_load_lds(rB_, (LAS void*)(uintptr_t)lb_, 16, vo_, so_, 0, 0); \
            __builtin_amdgcn_raw_ptr_buffer_load_lds(rB_, (LAS void*)(uintptr_t)(lb_ + 1024), 16, vo_, so_ + 32 * bgN, 0, 0); } } while (0)
#define BG_CONSUME(t) do { if constexpr (BG) { { int lq = lane; asm volatile("" : "+v"(lq)); \
            const LAS float* rp_ = (const LAS float*)(bgl + (lq >> 5) * 1024 + (lq & 31) * 4); \
            float x_[8]; _Pragma("unroll") for (int i_ = 0; i_ < 8; ++i_) x_[i_] = rp_[i_ * 32]; \
            u32x4 w_; w_.x = cvtpk(x_[0], x_[1]); w_.y = cvtpk(x_[2], x_[3]); w_.z = cvtpk(x_[4], x_[5]); w_.w = cvtpk(x_[6], x_[7]); \
            const int do_ = bgdst + (bgm == 1 ? ((t) >> 1) * 4194304 + ((t) & 1) * 2048 : (t) * 2097152); \
            const __amdgpu_buffer_rsrc_t rS_ = __builtin_amdgcn_make_buffer_rsrc((void*)(uintptr_t)(((unsigned long long)(unsigned)__builtin_amdgcn_readfirstlane(wsh_) << 32) | (unsigned long long)(unsigned)__builtin_amdgcn_readfirstlane(wsl_)), 0, __builtin_amdgcn_readfirstlane(bgnr), 0x00020000); \
            __builtin_amdgcn_raw_buffer_store_b128(w_, rS_, ((lq & 31) * bgK + (lq >> 5) * 8) * 2, do_, 0); SBAR(); } } } while (0)
        u32x4 st[3];
#define ST_LOAD0(t) do { const int sb = (t) * (KVBLK * D * 2); \
        if (grp == 0) { _Pragma("unroll") for (int i = 0; i < 3; ++i) st[i] = __builtin_amdgcn_raw_buffer_load_b128(rW, voK, (int)(unsigned)WS_K + sb + i * (16 * D * 2), 0); } \
        else { _Pragma("unroll") for (int i = 0; i < 3; ++i) st[i] = __builtin_amdgcn_raw_buffer_load_b128(rW, voV, (int)(unsigned)WS_V + sb + (i + 2) * (8 * D * 2), 0); } } while (0)
#define ST_LOAD1(t) do { const int sb = (t) * (KVBLK * D * 2); \
        if (grp == 0) { st[0] = __builtin_amdgcn_raw_buffer_load_b128(rW, voK, (int)(unsigned)WS_K + sb + 3 * (16 * D * 2), 0); \
                        st[1] = __builtin_amdgcn_raw_buffer_load_b128(rW, voV, (int)(unsigned)WS_V + sb, 0); st[2] = __builtin_amdgcn_raw_buffer_load_b128(rW, voV, (int)(unsigned)WS_V + sb + 8 * D * 2, 0); } \
        else { _Pragma("unroll") for (int i = 0; i < 3; ++i) st[i] = __builtin_amdgcn_raw_buffer_load_b128(rW, voV, (int)(unsigned)WS_V + sb + (i + 5) * (8 * D * 2), 0); } } while (0)
        const unsigned wsl_ = (unsigned)(uintptr_t)ws, wsh_ = (unsigned)((unsigned long long)(uintptr_t)ws >> 32);
#define ST_WRITE0(b) do { const int wk = wK + (b) * SHM_K, wv = wV + (b) * SHM_V; \
        if (grp == 0) { lds_write128<0>(wk, st[0]); lds_write128<4096>(wk, st[1]); lds_write128<8192>(wk, st[2]); } \
        else { lds_write128<8192>(wv, st[0]); lds_write128<8192 + 256>(wv, st[1]); lds_write128<16384>(wv, st[2]); } } while (0)
#define ST_WRITE1(b) do { const int wk = wK + (b) * SHM_K, wv = wV + (b) * SHM_V; \
        if (grp == 0) { lds_write128<12288>(wk, st[0]); lds_write128<0>(wv, st[1]); lds_write128<256>(wv, st[2]); } \
        else { lds_write128<16384 + 256>(wv, st[0]); lds_write128<24576>(wv, st[1]); lds_write128<24576 + 256>(wv, st[2]); } } while (0)
        { u32x4 keep0, keep1, keep2;
          ST_LOAD0(0); keep0 = st[0]; keep1 = st[1]; keep2 = st[2]; ST_LOAD1(0);
          { u32x4 t0 = st[0], t1 = st[1], t2 = st[2]; st[0] = keep0; st[1] = keep1; st[2] = keep2; ST_WRITE0(0); st[0] = t0; st[1] = t1; st[2] = t2; ST_WRITE1(0); } }
        LGKM_WAIT0(); __syncthreads();
        BG_ISSUE(0);
        if (grp == 1) __builtin_amdgcn_s_barrier();
#pragma unroll 1
        for (int t = 0; t < NT; ++t) {
            const int b = t & 1;
            const int tn = t + 1 < NT ? t + 1 : NT - 1;
            ST_LOAD0(tn);
            f32x16 p0 = f32x16{}, p1 = f32x16{}; float alpha; bf16x8 pa0, pa1, pa2, pa3;
            { const int kbuf = ldsb + OFF_K + b * SHM_K + r32 * 256;
              const int k0 = kbuf + ((0 * 32 + hi * 16) ^ x15), k1 = kbuf + ((1 * 32 + hi * 16) ^ x15), k2 = kbuf + ((2 * 32 + hi * 16) ^ x15), k3 = kbuf + ((3 * 32 + hi * 16) ^ x15);
              __builtin_amdgcn_s_setprio(2);
              if (mz) { qk_tile(p0, p1, k0, k1, k2, k3, qr); }
              else {
#pragma unroll
                  for (int r = 0; r < 16; ++r) { p0[r] = -m_reg; p1[r] = -m_reg; }
                  qk_tile(p0, p1, k0, k1, k2, k3, qr); }
              __builtin_amdgcn_s_setprio(0); }
            if constexpr (BG) { asm volatile("s_waitcnt vmcnt(3)" ::: "memory"); BG_CONSUME(t); }
            softmax_tile(p0, p1, m_reg, l_reg, mz, alpha, pa0, pa1, pa2, pa3);
            if (__any(alpha != 1.f)) { if (hi == 0) al_l[r32] = alpha; LGKM_WAIT0();
#pragma unroll
                for (int r = 0; r < 16; ++r) { const float a = al_l[crow(r, hi)];
#pragma unroll
                    for (int d = 0; d < 8; ++d) o[d][r] *= a; } }
            LGKM_WAIT0(); __builtin_amdgcn_s_barrier(); SBAR();
            const int vb = vrd + b * SHM_V;
            ST_WRITE0(b ^ 1); ST_LOAD1(tn); BG_ISSUE(tn);
            __builtin_amdgcn_s_setprio(1);
            pv_quad<0>(o, vb, pa0, pa1, pa2, pa3);
            pv_quad<4>(o, vb, pa0, pa1, pa2, pa3);
            __builtin_amdgcn_s_setprio(0);
            ST_WRITE1(b ^ 1);
            LGKM_WAIT0(); __builtin_amdgcn_s_barrier(); SBAR();
        }
        if (grp == 0) __builtin_amdgcn_s_barrier();
        if constexpr (BG) { VM_WAIT0(); }
#undef BG_ISSUE
#undef BG_RSRC
#undef BG_CONSUME
#undef ST_LOAD0
#undef ST_LOAD1
#undef ST_WRITE0
#undef ST_WRITE1
        if (hi == 0) li_l[r32] = l_reg; LGKM_WAIT0();
        const int voS = F.bid * (128 * 512 * 4) + tid * 4;
        if (comp == 0) {
#pragma unroll
            for (int r = 0; r < 16; ++r) { const float rl = __builtin_amdgcn_rcpf(li_l[crow(r, hi)]);
#pragma unroll
                for (int d = 0; d < 8; ++d) __builtin_amdgcn_raw_buffer_store_b32(__float_as_uint(o[d][r] * rl), rW, voS, (int)(unsigned)WS_OSCR + (d * 16 + r) * 2048, 0);
                SBAR(); }
        } else {
            const int vo = ((qb * 256 + wid * 32 + 4 * hi) * D + h * 256 + r32) * 2;
            const __amdgpu_buffer_rsrc_t rG = __builtin_amdgcn_make_buffer_rsrc((void*)subg, 0, VD * 4, 0x00020000);
            float gsub[8];
#pragma unroll
            for (int d = 0; d < 8; ++d) gsub[d] = __uint_as_float(__builtin_amdgcn_raw_buffer_load_b32(rG, r32 * 4, d * 128, 0));
            float ld[4][8], nx[4][8];
#define O0_LOAD(DST, G) do { _Pragma("unroll") for (int rr = 0; rr < 4; ++rr) _Pragma("unroll") for (int d = 0; d < 8; ++d) \
                DST[rr][d] = __uint_as_float(__builtin_amdgcn_raw_buffer_load_b32(rW, voS, (int)(unsigned)WS_OSCR + (d * 16 + 4 * (G) + rr) * 2048, 0)); } while (0)
            O0_LOAD(ld, 0);
#pragma unroll
            for (int g4 = 0; g4 < 4; ++g4) {
                if (g4 + 1 < 4) O0_LOAD(nx, g4 + 1);
                SBAR();
#pragma unroll
                for (int rr = 0; rr < 4; ++rr) { const int r = 4 * g4 + rr; const float rl = __builtin_amdgcn_rcpf(li_l[crow(r, hi)]) * lam; float acc = 0.f; float v[8];
#pragma unroll
                    for (int d = 0; d < 8; ++d) { v[d] = ld[rr][d] - o[d][r] * rl; acc += v[d] * v[d]; }
                    acc += __int_as_float(__builtin_amdgcn_ds_swizzle(__float_as_int(acc), 0x041F)); acc += __int_as_float(__builtin_amdgcn_ds_swizzle(__float_as_int(acc), 0x081F));
                    acc += __int_as_float(__builtin_amdgcn_ds_swizzle(__float_as_int(acc), 0x101F)); acc += __int_as_float(__builtin_amdgcn_ds_swizzle(__float_as_int(acc), 0x201F));
                    acc += __int_as_float(__builtin_amdgcn_ds_swizzle(__float_as_int(acc), 0x401F));
                    const float sc = __builtin_amdgcn_rsqf(acc * (1.0f / 256.0f) + RMS_EPS) * outscale;
#pragma unroll
                    for (int d = 0; d < 8; ++d) { const unsigned w = cvtpk(v[d] * sc * gsub[d], 0.f);
                        __builtin_amdgcn_raw_buffer_store_b16((short)(w & 0xffff), rW, vo, (int)(unsigned)WS_AO + (((r & 3) + 8 * (r >> 2)) * D + d * 32) * 2, 0); } }
                SBAR();
#pragma unroll
                for (int rr = 0; rr < 4; ++rr)
#pragma unroll
                    for (int d = 0; d < 8; ++d) ld[rr][d] = nx[rr][d];
            }
#undef O0_LOAD
        }
        __syncthreads();
    }
}
}

__device__ __forceinline__ void phase_attention(const Ctx& F, int j) {
    unsigned char* const ws = opaque_ws(F.ws);
    const int lane0 = phase_tid() & 63;
    const __amdgpu_buffer_rsrc_t rL = __builtin_amdgcn_make_buffer_rsrc((void*)(as_global(kargs()->in[IN_LAMBDA]) + (size_t)j * 4 * HD), 0, 4 * HD * 4, 0x00020000);
#define LF(i) __uint_as_float(__builtin_amdgcn_raw_buffer_load_b32(rL, lane0 * 4, (i) * 4, 0))
    float a = LF(0) * LF(HD) + LF(64) * LF(HD + 64);
    float b = LF(2 * HD) * LF(3 * HD) + LF(2 * HD + 64) * LF(3 * HD + 64);
#undef LF
    a = wave_sum(a); b = wave_sum(b);
    const float lam_init = (j == 0) ? 0.2f : 0.47071302f;
    const float lam = expf(a) - expf(b) + lam_init;
    const bf16_t* Q = (const bf16_t*)(ws + WS_Q); const bf16_t* K = (const bf16_t*)(ws + WS_K); const bf16_t* V = (const bf16_t*)(ws + WS_V);
    bf16_t* AO = (bf16_t*)(ws + WS_AO);
    const float* subg = as_global(kargs()->in[IN_SUBLN]) + (size_t)j * VD;
    if (j == 0 && F.G == 256) {
        int ui = 0;
        for (int u = F.bid; u < NH * (S / 256); u += F.G, ++ui) { const int h = u & 7, qb = u >> 3; att::attn_unit<true>(F, Q, K, V, AO, subg, lam, 1.0f - lam_init, h, qb, ui * 2); }
    } else {
        for (int u = F.bid; u < NH * (S / 256); u += F.G) { const int h = u & 7, qb = u >> 3; att::attn_unit<false>(F, Q, K, V, AO, subg, lam, 1.0f - lam_init, h, qb, 0); }
    }
}

__device__ __forceinline__ void phase_route(const Ctx& F, int layer, bool commit, int mode) {
    unsigned char* const ws = opaque_ws(F.ws);
    const bf16_t* MIX = (const bf16_t*)(ws + WS_Z); bf16_t* H1B = (bf16_t*)(ws + WS_H1B);
    KArgs KA = kargs(); const float* router_b = as_global(KA->in[IN_ROUTERB]);
    const bf16_t* Hs = (const bf16_t*)(ws + WS_HB);
    const float* g = as_global(KA->in[IN_LNG]) + (size_t)(layer * 2 + 0) * D; const float* bta = as_global(KA->in[IN_LNB]) + (size_t)(layer * 2 + 0) * D;
    int* cnt = (int*)(ws + WS_CTL + CTL_CNT) + layer * 64; int* seg = (int*)(ws + WS_SEG); float* gates = (float*)(ws + WS_GATE);
    const int tid = phase_tid(); const int lane = tid & 63, wid = __builtin_amdgcn_readfirstlane(tid >> 6);
    LAS float* lgp = (LAS float*)(F.lds);
    for (int tile = F.bid; tile < S / 64; tile += F.G) {
        const int tb = tile * 64;
        if (mode != 2) {
            f32x4 v[8]; u32x4 hq3[3][4], mq3[3][4];
#define RT_LOAD(V, MX, R) do { const bf16_t* hr_ = Hs + (size_t)(R) * D + lane * 8; const bf16_t* mr_ = MIX + (size_t)(R) * D + lane * 8; \
            _Pragma("unroll") for (int i = 0; i < 4; ++i) { V[i] = *(const u32x4*)(hr_ + 512 * i); MX[i] = *(const u32x4*)(mr_ + 512 * i); } } while (0)
            RT_LOAD(hq3[0], mq3[0], tb + wid * 8); RT_LOAD(hq3[1], mq3[1], tb + wid * 8 + 1);
            f32x4 gg[8], bb[8];
#pragma unroll
            for (int i = 0; i < 4; ++i) { gg[2 * i] = *(const f32x4*)(g + lane * 8 + 512 * i); gg[2 * i + 1] = *(const f32x4*)(g + lane * 8 + 512 * i + 4);
                bb[2 * i] = *(const f32x4*)(bta + lane * 8 + 512 * i); bb[2 * i + 1] = *(const f32x4*)(bta + lane * 8 + 512 * i + 4); }
#pragma unroll
            for (int r = 0; r < 8; ++r) {
                const int row = tb + wid * 8 + r;
                if (r + 2 < 8) RT_LOAD(hq3[(r + 2) % 3], mq3[(r + 2) % 3], row + 2);
#pragma unroll
                for (int i = 0; i < 4; ++i) { const u32x4 p = mq3[r % 3][i]; f32x4 m0, m1;
                    m0[0] = __uint_as_float(p.x << 16); m0[1] = __uint_as_float(p.x & 0xffff0000u); m0[2] = __uint_as_float(p.y << 16); m0[3] = __uint_as_float(p.y & 0xffff0000u);
                    m1[0] = __uint_as_float(p.z << 16); m1[1] = __uint_as_float(p.z & 0xffff0000u); m1[2] = __uint_as_float(p.w << 16); m1[3] = __uint_as_float(p.w & 0xffff0000u);
                    const u32x4 hq = hq3[r % 3][i]; f32x4 x0, x1;
                    x0[0] = __uint_as_float(hq.x << 16); x0[1] = __uint_as_float(hq.x & 0xffff0000u); x0[2] = __uint_as_float(hq.y << 16); x0[3] = __uint_as_float(hq.y & 0xffff0000u);
                    x1[0] = __uint_as_float(hq.z << 16); x1[1] = __uint_as_float(hq.z & 0xffff0000u); x1[2] = __uint_as_float(hq.w << 16); x1[3] = __uint_as_float(hq.w & 0xffff0000u);
                    v[2 * i] = x0 * ALPHA + m0; v[2 * i + 1] = x1 * ALPHA + m1; }
                float s = 0.f;
#pragma unroll
                for (int i = 0; i < 8; ++i) s += (v[i][0] + v[i][1]) + (v[i][2] + v[i][3]);
                const float mu = wave_sum(s) * (1.0f / D);
                float q = 0.f;
#pragma unroll
                for (int i = 0; i < 8; ++i) { const f32x4 d = v[i] - mu; q += (d[0] * d[0] + d[1] * d[1]) + (d[2] * d[2] + d[3] * d[3]); }
                const float rstd = __builtin_amdgcn_rsqf(wave_sum(q) * (1.0f / D) + LN_EPS);
                bf16_t* hb = H1B + (size_t)row * D + lane * 8;
#pragma unroll
                for (int i = 0; i < 4; ++i) {
                    const f32x4 g0 = gg[2 * i], g1 = gg[2 * i + 1], b0 = bb[2 * i], b1 = bb[2 * i + 1];
                    const f32x4 y0 = (v[2 * i] - mu) * rstd * g0 + b0, y1 = (v[2 * i + 1] - mu) * rstd * g1 + b1;
                    u32x4 w; w.x = cvtpk(y0[0], y0[1]); w.y = cvtpk(y0[2], y0[3]); w.z = cvtpk(y1[0], y1[1]); w.w = cvtpk(y1[2], y1[3]);
                    *(u32x4*)(hb + 512 * i) = w; }
                SBAR();
            }
#undef RT_LOAD
        }
        VM_WAIT0(); __syncthreads();
        if (mode == 1) continue;
        {
            constexpr int ROWB = 272, HALFB = 64 * ROWB, BUFB = 2 * HALFB;
            LAS unsigned char* Bs = F.lds + 32768;
            const int tg = wid & 3, eh = wid >> 2;
            f32x4 acc[2] = {(f32x4){0.f, 0.f, 0.f, 0.f}, (f32x4){0.f, 0.f, 0.f, 0.f}};
            const bf16_t* aph = H1B + (size_t)(tb + tg * 16 + (lane & 15)) * D + 8 * (lane >> 4);
            const int st_hl = tid >> 8, st_e = (tid >> 2) & 63, st_p = tid & 3;
            const bf16_t* sp = (const bf16_t*)(ws + WS_RT) + (size_t)(st_hl * NE + st_e) * D + st_p * 32;
            const int st_off = st_hl * HALFB + st_e * ROWB + st_p * 64;
            const int rd_off = (32 * eh + (lane & 15)) * ROWB + (lane >> 4) * 16;
            u32x4 bst[4]; u32x4 a0[4], n0[4];
#pragma unroll
            for (int j = 0; j < 4; ++j) bst[j] = *(const u32x4*)(sp + 8 * j);
#pragma unroll
            for (int i = 0; i < 4; ++i) { a0[i] = *(const u32x4*)(aph + 32 * i); }
#pragma unroll
            for (int j = 0; j < 4; ++j) *(LAS u32x4*)(Bs + st_off + 16 * j) = bst[j];
            __syncthreads();
#pragma unroll 1
            for (int c = 0; c < 16; ++c) {
                const int cn = c + 1 < 16 ? c + 1 : c;
#pragma unroll
                for (int j = 0; j < 4; ++j) bst[j] = *(const u32x4*)(sp + cn * 128 + 8 * j);
#pragma unroll
                for (int i = 0; i < 4; ++i) { n0[i] = *(const u32x4*)(aph + cn * 128 + 32 * i); }
                LAS unsigned char* Bc = Bs + (c & 1) * BUFB + rd_off;
#pragma unroll
                for (int i = 0; i < 4; ++i) {
                    const bf16x8 ah = *reinterpret_cast<const bf16x8*>(&a0[i]);
#pragma unroll
                    for (int nb = 0; nb < 2; ++nb) {
                        const bf16x8 bh = *(const LAS bf16x8*)(Bc + nb * 16 * ROWB + i * 64), bl = *(const LAS bf16x8*)(Bc + HALFB + nb * 16 * ROWB + i * 64);
                        acc[nb] = __builtin_amdgcn_mfma_f32_16x16x32_bf16(ah, bh, acc[nb], 0, 0, 0);
                        acc[nb] = __builtin_amdgcn_mfma_f32_16x16x32_bf16(ah, bl, acc[nb], 0, 0, 0); }
                }
#pragma unroll
                for (int j = 0; j < 4; ++j) *(LAS u32x4*)(Bs + ((c + 1) & 1) * BUFB + st_off + 16 * j) = bst[j];
#pragma unroll
                for (int i = 0; i < 4; ++i) { a0[i] = n0[i]; }
                __syncthreads();
            }
            LAS float* lg = lgp + tg * (16 * 64);
#pragma unroll
            for (int nb = 0; nb < 2; ++nb)
#pragma unroll
                for (int rg = 0; rg < 4; ++rg) lg[(4 * (lane >> 4) + rg) * 64 + 32 * eh + 16 * nb + (lane & 15)] = acc[nb][rg];
        }
        LGKM_WAIT0(); __syncthreads();
        if (commit) {
            const int T = tid >> 3, gi = tid & 7; const int tok = tb + T;
            const LAS float* r0 = lgp + (T >> 4) * (16 * 64) + (T & 15) * 64 + gi * 8;
            float m1 = -1e30f, m2 = -1e30f, r1 = 0.f, r2 = 0.f; int i1 = 0, i2 = 0;
#pragma unroll
            for (int e = 0; e < 8; ++e) { const float sg = 1.0f / (1.0f + expf(-r0[e])); const float sc = sg + router_b[gi * 8 + e];
                if (sc > m1) { m2 = m1; i2 = i1; r2 = r1; m1 = sc; i1 = e; r1 = sg; } else if (sc > m2) { m2 = sc; i2 = e; r2 = sg; } }
            float bgs = m1 + m2; int bgi = gi;
#define RT_BFLY(PAT) do { const float og = __int_as_float(__builtin_amdgcn_ds_swizzle(__float_as_int(bgs), PAT)); const int oi = __builtin_amdgcn_ds_swizzle(bgi, PAT); \
                if (og > bgs || (og == bgs && oi < bgi)) { bgs = og; bgi = oi; } } while (0)
            RT_BFLY(0x041F); RT_BFLY(0x081F); RT_BFLY(0x101F);
#undef RT_BFLY
            if (bgi == gi) {
                const int e1 = gi * 8 + i1, e2 = gi * 8 + i2;
                const float inv = 1.0f / (r1 + r2);
                const int p1 = atomicAdd(cnt + e1, 1), p2 = atomicAdd(cnt + e2, 1);
                seg[(size_t)e1 * SEGCAP + p1] = tok * 2; seg[(size_t)e2 * SEGCAP + p2] = tok * 2 + 1;
                gates[tok * 2] = r1 * inv; gates[tok * 2 + 1] = r2 * inv;
            }
        }
        __syncthreads();
    }
}

__device__ __forceinline__ void phase_combine(const Ctx& F, int layer, float* outp, bool write_hb) {
    unsigned char* const ws = opaque_ws(F.ws);
    const bf16_t* H1B = (const bf16_t*)(ws + WS_H1B); const bf16_t* Y = (const bf16_t*)(ws + WS_Y); bf16_t* HB = (bf16_t*)(ws + WS_HB);
    KArgs KA = kargs();
    const float* g = as_global(KA->in[IN_LNG]) + (size_t)(layer * 2 + 1) * D; const float* bta = as_global(KA->in[IN_LNB]) + (size_t)(layer * 2 + 1) * D;
    const int tid = phase_tid(); const int lane = tid & 63, wid = __builtin_amdgcn_readfirstlane(tid >> 6);
    f32x4 gg[8], bb[8];
#pragma unroll
    for (int i = 0; i < 4; ++i) { gg[2 * i] = *(const f32x4*)(g + lane * 8 + 512 * i); gg[2 * i + 1] = *(const f32x4*)(g + lane * 8 + 512 * i + 4);
        bb[2 * i] = *(const f32x4*)(bta + lane * 8 + 512 * i); bb[2 * i + 1] = *(const f32x4*)(bta + lane * 8 + 512 * i + 4); }
    u32x4 ha[4], na[4]; u32x4 yp[4], yq[4], np[4], nq[4];
    int row = F.bid * 8 + wid;
#define CMB_LOAD(A, P, Q, R) do { const bf16_t* hh_ = H1B + (size_t)(R) * D + lane * 8; const bf16_t* y0_ = Y + (size_t)(2 * (R)) * D + lane * 8; \
        _Pragma("unroll") for (int i = 0; i < 4; ++i) { A[i] = *(const u32x4*)(hh_ + 512 * i); \
            P[i] = *(const u32x4*)(y0_ + 512 * i); Q[i] = *(const u32x4*)(y0_ + D + 512 * i); } } while (0)
    if (row < S) CMB_LOAD(ha, yp, yq, row);
    for (; row < S; row += F.G * 8) {
        const int nrow = row + F.G * 8;
        if (nrow < S) CMB_LOAD(na, np, nq, nrow);
        f32x4 v[8];
#pragma unroll
        for (int i = 0; i < 4; ++i) {
            const u32x4 p = yp[i], q = yq[i];
            f32x4 s0, s1;
            s0[0] = __uint_as_float(p.x << 16) + __uint_as_float(q.x << 16); s0[1] = __uint_as_float(p.x & 0xffff0000u) + __uint_as_float(q.x & 0xffff0000u);
            s0[2] = __uint_as_float(p.y << 16) + __uint_as_float(q.y << 16); s0[3] = __uint_as_float(p.y & 0xffff0000u) + __uint_as_float(q.y & 0xffff0000u);
            s1[0] = __uint_as_float(p.z << 16) + __uint_as_float(q.z << 16); s1[1] = __uint_as_float(p.z & 0xffff0000u) + __uint_as_float(q.z & 0xffff0000u);
            s1[2] = __uint_as_float(p.w << 16) + __uint_as_float(q.w << 16); s1[3] = __uint_as_float(p.w & 0xffff0000u) + __uint_as_float(q.w & 0xffff0000u);
            const u32x4 hh = ha[i]; f32x4 h0, h1v;
            h0[0] = __uint_as_float(hh.x << 16); h0[1] = __uint_as_float(hh.x & 0xffff0000u); h0[2] = __uint_as_float(hh.y << 16); h0[3] = __uint_as_float(hh.y & 0xffff0000u);
            h1v[0] = __uint_as_float(hh.z << 16); h1v[1] = __uint_as_float(hh.z & 0xffff0000u); h1v[2] = __uint_as_float(hh.w << 16); h1v[3] = __uint_as_float(hh.w & 0xffff0000u);
            v[2 * i] = h0 * ALPHA + s0; v[2 * i + 1] = h1v * ALPHA + s1; }
        float s = 0.f;
#pragma unroll
        for (int i = 0; i < 8; ++i) s += (v[i][0] + v[i][1]) + (v[i][2] + v[i][3]);
        const float mu = wave_sum(s) * (1.0f / D);
        float q = 0.f;
#pragma unroll
        for (int i = 0; i < 8; ++i) { const f32x4 d = v[i] - mu; q += (d[0] * d[0] + d[1] * d[1]) + (d[2] * d[2] + d[3] * d[3]); }
        const float rstd = __builtin_amdgcn_rsqf(wave_sum(q) * (1.0f / D) + LN_EPS);
        float* orow = outp + (size_t)row * D + lane * 8; bf16_t* hb = HB + (size_t)row * D + lane * 8;
#pragma unroll
        for (int i = 0; i < 4; ++i) {
            const f32x4 y0v = (v[2 * i] - mu) * rstd * gg[2 * i] + bb[2 * i], y1v = (v[2 * i + 1] - mu) * rstd * gg[2 * i + 1] + bb[2 * i + 1];
            if (!write_hb) { *(f32x4*)(orow + 512 * i) = y0v; *(f32x4*)(orow + 512 * i + 4) = y1v; }
            else { u32x4 w; w.x = cvtpk(y0v[0], y0v[1]); w.y = cvtpk(y0v[2], y0v[3]); w.z = cvtpk(y1v[0], y1v[1]); w.w = cvtpk(y1v[2], y1v[3]);
                *(u32x4*)(hb + 512 * i) = w; } }
#pragma unroll
        for (int i = 0; i < 4; ++i) { ha[i] = na[i]; yp[i] = np[i]; yq[i] = nq[i]; }
    }
#undef CMB_LOAD
}

__device__ __forceinline__ void phase_poolprep(const Ctx& F, const bf16_t* H) {
    unsigned char* const ws = opaque_ws(F.ws);
    bf16_t* Dm = (bf16_t*)(ws + WS_AO);
    const int tid = phase_tid(); const int c8 = (tid & 255) * 8, rh = tid >> 8;
    const int half = 1 << (c8 >> 9);
#define PP_LD(A0, A1, R) do { const u32x4 p_ = *(const u32x4*)(H + (size_t)(R) * D + c8); \
        A0[0] = __uint_as_float(p_.x << 16); A0[1] = __uint_as_float(p_.x & 0xffff0000u); A0[2] = __uint_as_float(p_.y << 16); A0[3] = __uint_as_float(p_.y & 0xffff0000u); \
        A1[0] = __uint_as_float(p_.z << 16); A1[1] = __uint_as_float(p_.z & 0xffff0000u); A1[2] = __uint_as_float(p_.w << 16); A1[3] = __uint_as_float(p_.w & 0xffff0000u); } while (0)
    for (int chunk = F.bid; chunk < S / 64; chunk += F.G) {
        const int t0 = chunk * 64 + rh * 32;
        f32x4 s0 = {0.f, 0.f, 0.f, 0.f}, s1 = {0.f, 0.f, 0.f, 0.f};
        for (int r4 = t0 - half; r4 < t0 + half; r4 += 4) {
            u32x4 pw[4];
#pragma unroll
            for (int q = 0; q < 4; ++q) { const int r = r4 + q; pw[q] = *(const u32x4*)(H + (size_t)(r < 0 ? 0 : r >= S ? S - 1 : r) * D + c8); }
#pragma unroll
            for (int q = 0; q < 4; ++q) { const int r = r4 + q; const float wq = (r >= 0 && r < S && r < t0 + half) ? 1.f : 0.f; f32x4 a0, a1;
                a0[0] = __uint_as_float(pw[q].x << 16); a0[1] = __uint_as_float(pw[q].x & 0xffff0000u); a0[2] = __uint_as_float(pw[q].y << 16); a0[3] = __uint_as_float(pw[q].y & 0xffff0000u);
                a1[0] = __uint_as_float(pw[q].z << 16); a1[1] = __uint_as_float(pw[q].z & 0xffff0000u); a1[2] = __uint_as_float(pw[q].w << 16); a1[3] = __uint_as_float(pw[q].w & 0xffff0000u);
                s0 += a0 * wq; s1 += a1 * wq; }
        }
#define PP_UP(A0, A1, P) do { const u32x4 p_ = (P); \
        A0[0] = __uint_as_float(p_.x << 16); A0[1] = __uint_as_float(p_.x & 0xffff0000u); A0[2] = __uint_as_float(p_.y << 16); A0[3] = __uint_as_float(p_.y & 0xffff0000u); \
        A1[0] = __uint_as_float(p_.z << 16); A1[1] = __uint_as_float(p_.z & 0xffff0000u); A1[2] = __uint_as_float(p_.w << 16); A1[3] = __uint_as_float(p_.w & 0xffff0000u); } while (0)
#pragma unroll 1
        for (int t4 = t0; t4 < t0 + 32; t4 += 4) {
            u32x4 px[4], pa[4], pd[4];
#pragma unroll
            for (int q = 0; q < 4; ++q) { const int t = t4 + q, ra = t + half, rd = t - half;
                px[q] = *(const u32x4*)(H + (size_t)t * D + c8); pa[q] = *(const u32x4*)(H + (size_t)(ra < S ? ra : S - 1) * D + c8); pd[q] = *(const u32x4*)(H + (size_t)(rd >= 0 ? rd : 0) * D + c8); }
#pragma unroll
            for (int q = 0; q < 4; ++q) { const int t = t4 + q, ra = t + half, rd = t - half;
                const int lo = rd < 0 ? 0 : rd, hiw = ra > S ? S : ra;
                const float inv = 1.0f / (float)(hiw - lo);
                f32x4 x0, x1; PP_UP(x0, x1, px[q]);
                const f32x4 d0 = s0 * inv - x0, d1 = s1 * inv - x1;
                u32x4 w; w.x = cvtpk(d0[0], d0[1]); w.y = cvtpk(d0[2], d0[3]); w.z = cvtpk(d1[0], d1[1]); w.w = cvtpk(d1[2], d1[3]);
                *(u32x4*)(Dm + (size_t)t * D + c8) = w;
                const float wa = ra < S ? 1.f : 0.f, wd = rd >= 0 ? 1.f : 0.f; f32x4 a0, a1, e0, e1;
                PP_UP(a0, a1, pa[q]); PP_UP(e0, e1, pd[q]);
                s0 += a0 * wa - e0 * wd; s1 += a1 * wa - e1 * wd; }
        }
#undef PP_UP
    }
#undef PP_LD
}

__device__ __forceinline__ void moe_tables(const Ctx& F, int layer) {
    unsigned char* const ws = opaque_ws(F.ws);
    LAS int* tab = (LAS int*)(F.lds + LDS_MISC + 64);
    const int* cnt = (const int*)(ws + WS_CTL + CTL_CNT) + layer * 64;
    const int tid = phase_tid();
    if (tid < 64) tab[tid] = cnt[tid];
    __syncthreads();
    if (tid == 0) { int to = 0, ro = 0; for (int e = 0; e < 64; ++e) { tab[64 + e] = to; tab[129 + e] = ro; const int c = tab[e]; to += (c + 255) >> 8; ro += c; } tab[128] = to; tab[193] = ro; }
    __syncthreads();
}

constexpr int N_PHASES = 1 + 8 * DEPTH;
__global__ void __launch_bounds__(NTHREADS, 2) fwd(Args args) {
    extern __shared__ __attribute__((aligned(16))) unsigned char lds_raw[];
    Ctx F;
    F.ws = as_global(args.ws); F.lds = (LAS unsigned char*)lds_raw; F.wv = __builtin_amdgcn_readfirstlane(threadIdx.x >> 6);
    F.G = gridDim.x; F.bid = blockIdx.x;
    const int lo = args.ph_lo, hi = args.ph_hi;
    XcdBarrier bar; bar.bar = (unsigned*)(F.ws + WS_CTL); bar.x = 0; bar.st = (volatile LAS unsigned*)(F.lds + LDS_MISC);
    if (threadIdx.x < 4) ((LAS unsigned*)(F.lds + LDS_MISC))[threadIdx.x] = 0u;
    __syncthreads();
    const bool multi = (hi - lo) > 1;
    if (multi) bar = xcd_barrier_post((unsigned*)(F.ws + WS_CTL), (volatile LAS unsigned*)(F.lds + LDS_MISC));
#define IN(k) (lo <= (k) && (k) < hi)
#define SEAM(k) do { if (IN(k) && IN((k) + 1)) { xcd_barrier(bar); if (PROBE_BAR) xcd_barrier(bar); } } while (0)

    if constexpr (PHMASK & 1) if (IN(0)) { REPEAT(REP_PRO) phase_prologue(F); }
    SEAM(0);
#pragma unroll 1
    for (int layer = 0; layer < DEPTH; ++layer) {
        const int pb = 1 + 8 * layer; const int j = layer >> 1;
        if ((layer & 1) == 0) {
            if constexpr (PHMASK & 2) if (IN(pb + 0)) {     unsigned char* const ws = opaque_ws(F.ws);
                pg8::DenseOrder Sd; Sd.init(ws + WS_HB, ws + WS_WQKV + (size_t)j * 6144 * 2048 * 2, D, D, S, 3 * D, F.G, F.bid);
                pg8::EpiQKV E{(bf16_t*)(ws + WS_Q), (const float*)(ws + WS_ROPE)};
                REPEAT(REP_GEMM) pg8::gemm_phase<pg8::EpiQKV, pg8::DenseOrder, false>(F.lds, F.wv, D, D, D, Sd, E);
            }
            SEAM(pb + 0);
            if constexpr (PHMASK & 4) if (IN(pb + 1)) { REPEAT(REP_ATT) phase_attention(F, j); }
            SEAM(pb + 1);
            if constexpr (PHMASK & 8) if (IN(pb + 2)) {     unsigned char* const ws = opaque_ws(F.ws);
                pg8::DenseOrder Sd; Sd.init(ws + WS_AO, ws + WS_WO + (size_t)j * 2048 * 2048 * 2, D, D, S, D, F.G, F.bid);
                pg8::EpiMix E{(bf16_t*)(ws + WS_Z), nullptr};
                REPEAT(REP_GEMM) pg8::gemm_phase<pg8::EpiMix, pg8::DenseOrder, false>(F.lds, F.wv, D, D, D, Sd, E);
            }
            SEAM(pb + 2);
        } else {
            if constexpr (PHMASK & 16) if (IN(pb + 0)) { REPEAT(REP_TOK) phase_poolprep(F, (const bf16_t*)(opaque_ws(F.ws) + WS_HB)); }
            SEAM(pb + 0);
            if constexpr (PHMASK & 32) if (IN(pb + 1)) {     unsigned char* const ws = opaque_ws(F.ws);
                pg8::PoolOrder Sp{(const char*)(ws + WS_AO), (const char*)(ws + WS_WPOOL + (size_t)j * 4 * 512 * 512 * 2), F.G, F.bid};
                pg8::EpiMix E{(bf16_t*)(ws + WS_Z), as_global(kargs()->in[IN_POOLSC]) + (size_t)j * D};
                REPEAT(REP_GEMM) pg8::gemm_phase<pg8::EpiMix, pg8::PoolOrder, false>(F.lds, F.wv, 512, D, 512, Sp, E);
            }
            SEAM(pb + 1);
        }
        if constexpr (PHMASK & 64) if (IN(pb + 3)) { REPEAT(REP_ROUTE) phase_route(F, layer, rep_ == REP_ROUTE - 1, rep_ == REP_ROUTE - 1 ? 0 : PROBE_RMODE); }
        SEAM(pb + 3);
        if constexpr (PHMASK & 128) if (IN(pb + 4)) {         unsigned char* const ws = opaque_ws(F.ws);
            moe_tables(F, layer);
            pg8::MoeOrder Sm{(const LAS int*)(F.lds + LDS_MISC + 64), (const char*)(ws + WS_H1B), (const char*)(ws + WS_WIN + (size_t)layer * 64 * 1024 * 2048 * 2), (const int*)(ws + WS_SEG), 4, F.G, F.bid, 0, (size_t)1024 * 2048 * 2};
            pg8::EpiMoeIn E{(bf16_t*)(ws + WS_HACT)};
            REPEAT(REP_MOE) pg8::gemm_phase<pg8::EpiMoeIn, pg8::MoeOrder, true>(F.lds, F.wv, D, D, D, Sm, E);
        }
        SEAM(pb + 4);
        if constexpr (PHMASK & 256) if (IN(pb + 5)) {         unsigned char* const ws = opaque_ws(F.ws);
            moe_tables(F, layer);
            pg8::MoeOrder Sm{(const LAS int*)(F.lds + LDS_MISC + 64), (const char*)(ws + WS_HACT), (const char*)(ws + WS_WOUT + (size_t)layer * 64 * 2048 * 512 * 2), (const int*)(ws + WS_SEG), 8, F.G, F.bid, 1, (size_t)2048 * 512 * 2};
            pg8::EpiMoeOut E{(bf16_t*)(ws + WS_Y), (const float*)(ws + WS_GATE)};
            REPEAT(REP_MOE) pg8::gemm_phase<pg8::EpiMoeOut, pg8::MoeOrder, false>(F.lds, F.wv, DFF, DFF, DFF, Sm, E);
        }
        SEAM(pb + 5);
        if constexpr (PHMASK & 512) if (IN(pb + 6)) { REPEAT(REP_TOK) phase_combine(F, layer, as_global(kargs()->out), layer != DEPTH - 1); }
        if (layer + 1 < DEPTH) SEAM(pb + 6);
    }
#undef IN
#undef SEAM
}

extern "C" void kernel_launch(void* const* d_in, const int* in_sizes, int n_in, void* d_out, int out_size, void* d_ws, size_t ws_size, hipStream_t stream) {
    static int grid = 0;
    if (grid == 0) {
        if (n_in != 13 || out_size != S * D || ws_size < WS_END) { fprintf(stderr, "kernel_launch: unexpected shapes (n_in %d out %d ws %zu, need %zu)\n", n_in, out_size, ws_size, (size_t)WS_END); grid = -1; return; }
        int dev = 0, cus = 0, per_cu = 0;
        if (hipGetDevice(&dev) != hipSuccess || hipDeviceGetAttribute(&cus, hipDeviceAttributeMultiprocessorCount, dev) != hipSuccess) { grid = -1; return; }
        if (hipFuncSetAttribute((const void*)fwd, hipFuncAttributeMaxDynamicSharedMemorySize, LDS_BYTES) != hipSuccess) { fprintf(stderr, "kernel_launch: hipFuncSetAttribute failed\n"); grid = -1; return; }
        if (hipOccupancyMaxActiveBlocksPerMultiprocessor(&per_cu, (const void*)fwd, NTHREADS, LDS_BYTES) != hipSuccess || per_cu < 1) { fprintf(stderr, "kernel_launch: occupancy query says %d\n", per_cu); }
        (void)hipGetLastError();
        grid = cus;
    }
    if (grid < 0) return;
    (void)hipMemsetAsync((char*)d_ws + WS_CTL, 0, CTL_ZERO_BYTES, stream);
    Args a{};
    for (int i = 0; i < 13; ++i) a.in[i] = (const float*)d_in[i];
    a.out = (float*)d_out; a.ws = (unsigned char*)d_ws;
#if ONE_LAUNCH
    a.ph_lo = 0; a.ph_hi = N_PHASES;
    hipLaunchKernelGGL(fwd, dim3(grid), dim3(NTHREADS), LDS_BYTES, stream, a);
#else
    for (int p = 0; p < N_PHASES; ++p) {
        const int sub = (p - 1) & 7, layer = (p - 1) >> 3;
        if (p > 0 && (sub == 7 || ((layer & 1) == 1 && sub == 2))) continue;
        a.ph_lo = p; a.ph_hi = p + 1;
        hipLaunchKernelGGL(fwd, dim3(grid), dim3(NTHREADS), LDS_BYTES, stream, a);
    }
#endif
}
```
